# Optimizing an MI355X kernel written in HIP

```python
import jax, jax.numpy as jnp
from jax import lax
import numpy as np

D_MODEL = 1024
BATCH = 4
SEQ = 8192
DEPTH = 1
DEC_BATCH = 32
DEC_SEQ = 64
PAST_LEN = 2048

CHUNK = 64
Q_BLOCK = 128
MIX_WIDTH = D_MODEL
SB_HEADS = 8
SB_HEAD_DIM = 64
SB_WIDTH = SB_HEADS * SB_HEAD_DIM
RET_HEADS = 4
RET_HEAD_DIM = 128
RET_WIDTH = RET_HEADS * RET_HEAD_DIM
IN_WIDTH = 3 * SB_WIDTH + 4 * RET_WIDTH
D_FF = 2816
N_MOD = 9
ROPE_BASE = 10000.0
NORM_EPS = 1e-6
MACARON_WEIGHT = 0.5

kernel_name = 'hymba_stickbreak_retention_macaron_step'


def rms_norm(x, gain):
    xf = x.astype(jnp.float32)
    inv = lax.rsqrt(jnp.mean(xf * xf, axis=-1, keepdims=True) + NORM_EPS)
    return (xf * inv * gain.astype(jnp.float32)).astype(x.dtype)


def modulate(x, gain, shift, scale):
    return rms_norm(x, gain) * (1 + scale[:, None, :]) + shift[:, None, :]


def swiglu_ffn(h, w_up, w_down):
    gate, up = jnp.split(h @ w_up, 2, axis=-1)
    return (jax.nn.silu(gate) * up) @ w_down


def rope(x, pos):
    half = x.shape[-1] // 2
    inv_freq = ROPE_BASE ** (-jnp.arange(half, dtype=jnp.float32) / half)
    ang = pos.astype(jnp.float32)[:, None] * inv_freq[None, :]
    cos = jnp.cos(ang)[None, :, None, :]
    sin = jnp.sin(ang)[None, :, None, :]
    x1, x2 = x[..., :half], x[..., half:]
    return jnp.concatenate([x1 * cos - x2 * sin, x1 * sin + x2 * cos], axis=-1)


def head_group_norm(y):
    mu = jnp.mean(y, axis=-1, keepdims=True)
    yc = y - mu
    return yc * lax.rsqrt(jnp.mean(yc * yc, axis=-1, keepdims=True) + NORM_EPS)


def retention_log_decay():
    return jnp.log1p(-jnp.exp2(-5.0 - jnp.arange(RET_HEADS, dtype=jnp.float32)))


def stick_breaking(q, k, v, q_pos, k_pos):
    z = jnp.einsum('bqhd,bkhd->bhqk', q.astype(jnp.float32), k.astype(jnp.float32)) * SB_HEAD_DIM ** -0.5
    mask = k_pos[None, :] < q_pos[:, None]
    log_rest = jnp.where(mask, jax.nn.log_sigmoid(-z), 0.0)
    between = lax.cumsum(log_rest, axis=3, reverse=True) - log_rest
    weights = jnp.where(mask, jnp.exp(jax.nn.log_sigmoid(z) + between), 0.0)
    return jnp.einsum('bhqk,bkhd->bqhd', weights, v.astype(jnp.float32))


def stick_breaking_blocked(q, k, v, pos):
    B, T, H, d = q.shape
    nb = T // Q_BLOCK
    qb = q.reshape(B, nb, Q_BLOCK, H, d).transpose(1, 0, 2, 3, 4)
    pb = pos.reshape(nb, Q_BLOCK)
    out = lax.map(lambda a: stick_breaking(a[0], k, v, a[1], pos), (qb, pb))
    return out.transpose(1, 0, 2, 3, 4).reshape(B, T, H, d)


def retention(q, k, v, s0):
    B, T, H, dk = q.shape
    dv = v.shape[-1]
    c = min(CHUNK, T)
    n = T // c
    lg = retention_log_decay()
    idx = jnp.arange(c, dtype=jnp.float32)
    diff = idx[:, None] - idx[None, :]
    intra_decay = jnp.where(diff[None] >= 0,
                            jnp.exp(jnp.maximum(diff, 0.0)[None] * lg[:, None, None]), 0.0)
    q_decay = jnp.exp((idx + 1.0)[:, None] * lg[None, :])
    k_decay = jnp.exp((c - 1.0 - idx)[:, None] * lg[None, :])
    chunk_decay = jnp.exp(c * lg)
    qc = q.reshape(B, n, c, H, dk)
    kc = k.reshape(B, n, c, H, dk)
    vc = v.reshape(B, n, c, H, dv)
    scores = jnp.einsum('bnihd,bnjhd->bnhij', qc, kc) * intra_decay
    intra = jnp.einsum('bnhij,bnjhe->bnihe', scores, vc)
    kv = jnp.einsum('bnjhd,bnjhe->nbhde', kc * k_decay[:, :, None], vc)
    q_in = (qc * q_decay[:, :, None]).transpose(1, 0, 2, 3, 4)

    def step(S, xs):
        q_n, kv_n = xs
        cross = jnp.einsum('bihd,bhde->bihe', q_n, S)
        return chunk_decay[None, :, None, None] * S + kv_n, cross

    s_final, cross = lax.scan(step, s0.astype(jnp.float32), (q_in, kv))
    out = intra + cross.transpose(1, 0, 2, 3, 4)
    return out.reshape(B, T, H, dv), s_final


def trunk_layer(x, c, pos, sb_k_past, sb_v_past, ret_s0,
                w_ada, b_ada, norm_ffn1, norm_mix, norm_ffn2,
                ffn1_w_up, ffn1_w_down, w_in, sb_q_gain, sb_k_gain, w_out,
                ffn2_w_up, ffn2_w_down):
    B, T = x.shape[0], x.shape[1]
    mod = jax.nn.silu(c) @ w_ada + b_ada
    sh1, sc1, g1, sh2, sc2, g2, sh3, sc3, g3 = jnp.split(mod, N_MOD, axis=-1)

    h = modulate(x, norm_ffn1, sh1, sc1)
    x = x + MACARON_WEIGHT * g1[:, None, :] * swiglu_ffn(h, ffn1_w_up, ffn1_w_down)

    h = modulate(x, norm_mix, sh2, sc2)
    proj = h @ w_in
    splits = [SB_WIDTH, 2 * SB_WIDTH, 3 * SB_WIDTH, 3 * SB_WIDTH + RET_WIDTH,
              3 * SB_WIDTH + 2 * RET_WIDTH, 3 * SB_WIDTH + 3 * RET_WIDTH]
    sb_q, sb_k, sb_v, r_q, r_k, r_v, r_g = jnp.split(proj, splits, axis=-1)
    sb_q = rms_norm(sb_q.reshape(B, T, SB_HEADS, SB_HEAD_DIM), sb_q_gain)
    sb_k = rms_norm(sb_k.reshape(B, T, SB_HEADS, SB_HEAD_DIM), sb_k_gain)
    sb_v = sb_v.reshape(B, T, SB_HEADS, SB_HEAD_DIM)
    r_q = rope(r_q.reshape(B, T, RET_HEADS, RET_HEAD_DIM).astype(jnp.float32), pos)
    r_k = rope(r_k.reshape(B, T, RET_HEADS, RET_HEAD_DIM).astype(jnp.float32), pos) * RET_HEAD_DIM ** -0.5
    r_v = r_v.reshape(B, T, RET_HEADS, RET_HEAD_DIM).astype(jnp.float32)

    if sb_k_past is None:
        sb_o = stick_breaking_blocked(sb_q, sb_k, sb_v, pos)
        ret_s0 = jnp.zeros((B, RET_HEADS, RET_HEAD_DIM, RET_HEAD_DIM), jnp.float32)
    else:
        k_all = jnp.concatenate([sb_k_past.astype(sb_k.dtype), sb_k], axis=1)
        v_all = jnp.concatenate([sb_v_past.astype(sb_v.dtype), sb_v], axis=1)
        k_pos = jnp.arange(k_all.shape[1], dtype=jnp.int32)
        sb_o = stick_breaking(sb_q, k_all, v_all, pos, k_pos)
    ret_o, ret_state = retention(r_q, r_k, r_v, ret_s0)

    mixed = jnp.concatenate(
        [sb_o.reshape(B, T, SB_WIDTH).astype(x.dtype),
         jax.nn.silu(r_g) * head_group_norm(ret_o).reshape(B, T, RET_WIDTH).astype(x.dtype)],
        axis=-1) @ w_out
    x = x + g2[:, None, :] * mixed

    h = modulate(x, norm_ffn2, sh3, sc3)
    x = x + MACARON_WEIGHT * g3[:, None, :] * swiglu_ffn(h, ffn2_w_up, ffn2_w_down)
    return x, sb_k, sb_v, ret_state


def setup_inputs(seed: int = 0) -> dict:
    key = jax.random.key(seed)
    ks = jax.random.split(key, 20)

    def normal(k, shape, scale):
        return jax.random.normal(k, shape, jnp.float32) * scale

    return {
        'x_prompt': normal(ks[0], (BATCH, SEQ, D_MODEL), 1.0),
        'x_sample': normal(ks[1], (DEC_BATCH, DEC_SEQ, D_MODEL), 1.0),
        'cache_sb_k': normal(ks[2], (DEPTH, DEC_BATCH, PAST_LEN, SB_HEADS, SB_HEAD_DIM), 1.0),
        'cache_sb_v': normal(ks[3], (DEPTH, DEC_BATCH, PAST_LEN, SB_HEADS, SB_HEAD_DIM), 1.0),
        'state_ret': normal(ks[4], (DEPTH, DEC_BATCH, RET_HEADS, RET_HEAD_DIM, RET_HEAD_DIM), 0.5),
        'c_prompt': normal(ks[5], (BATCH, D_MODEL), 1.0),
        'c_sample': normal(ks[6], (DEC_BATCH, D_MODEL), 1.0),
        'w_ada': normal(ks[7], (DEPTH, D_MODEL, N_MOD * D_MODEL), 0.5 * D_MODEL ** -0.5),
        'b_ada': normal(ks[8], (DEPTH, N_MOD * D_MODEL), 0.02),
        'norm_ffn1': 1.0 + normal(ks[9], (DEPTH, D_MODEL), 0.02),
        'norm_mix': 1.0 + normal(ks[10], (DEPTH, D_MODEL), 0.02),
        'norm_ffn2': 1.0 + normal(ks[11], (DEPTH, D_MODEL), 0.02),
        'ffn1_w_up': normal(ks[12], (DEPTH, D_MODEL, 2 * D_FF), D_MODEL ** -0.5),
        'ffn1_w_down': normal(ks[13], (DEPTH, D_FF, D_MODEL), D_FF ** -0.5),
        'w_in': normal(ks[14], (DEPTH, D_MODEL, IN_WIDTH), D_MODEL ** -0.5),
        'sb_q_gain': 1.0 + normal(ks[15], (DEPTH, SB_HEAD_DIM), 0.02),
        'sb_k_gain': 1.0 + normal(ks[16], (DEPTH, SB_HEAD_DIM), 0.02),
        'w_out': normal(ks[17], (DEPTH, MIX_WIDTH, D_MODEL), MIX_WIDTH ** -0.5),
        'ffn2_w_up': normal(ks[18], (DEPTH, D_MODEL, 2 * D_FF), D_MODEL ** -0.5),
        'ffn2_w_down': normal(ks[19], (DEPTH, D_FF, D_MODEL), D_FF ** -0.5),
    }


def reference(x_prompt, x_sample, cache_sb_k, cache_sb_v, state_ret, c_prompt, c_sample,
              w_ada, b_ada, norm_ffn1, norm_mix, norm_ffn2, ffn1_w_up, ffn1_w_down,
              w_in, sb_q_gain, sb_k_gain, w_out, ffn2_w_up, ffn2_w_down):
    pos_p = jnp.arange(x_prompt.shape[1], dtype=jnp.int32)
    pos_s = cache_sb_k.shape[2] + jnp.arange(x_sample.shape[1], dtype=jnp.int32)
    y_prompt, y_sample = x_prompt, x_sample
    kp_list, vp_list, sp_list, ks_list, vs_list, ss_list = [], [], [], [], [], []
    for l in range(DEPTH):
        layer_w = (w_ada[l], b_ada[l], norm_ffn1[l], norm_mix[l], norm_ffn2[l],
                   ffn1_w_up[l], ffn1_w_down[l], w_in[l], sb_q_gain[l], sb_k_gain[l],
                   w_out[l], ffn2_w_up[l], ffn2_w_down[l])
        y_prompt, kp, vp, sp = trunk_layer(y_prompt, c_prompt, pos_p, None, None, None, *layer_w)
        y_sample, ksm, vsm, ssm = trunk_layer(y_sample, c_sample, pos_s, cache_sb_k[l],
                                              cache_sb_v[l], state_ret[l], *layer_w)
        kp_list.append(kp)
        vp_list.append(vp)
        sp_list.append(sp)
        ks_list.append(ksm)
        vs_list.append(vsm)
        ss_list.append(ssm)
    new_sb_k_prompt = jnp.stack(kp_list)
    new_sb_v_prompt = jnp.stack(vp_list)
    new_ret_state_prompt = jnp.stack(sp_list)
    new_sb_k_sample = jnp.stack(ks_list)
    new_sb_v_sample = jnp.stack(vs_list)
    new_ret_state_sample = jnp.stack(ss_list)
    return (y_prompt, y_sample, new_sb_k_prompt, new_sb_v_prompt, new_ret_state_prompt,
            new_sb_k_sample, new_sb_v_sample, new_ret_state_sample)
```

```cpp
#include <hip/hip_runtime.h>
#include <hip/hip_cooperative_groups.h>
#include <cstdio>
#include <cstdint>
namespace cg = cooperative_groups;
namespace pg8 {
#define PG8_LAS __attribute__((address_space(3)))
typedef unsigned short bf16_t;
typedef short bf16x8 __attribute__((ext_vector_type(8)));
typedef float f32x4 __attribute__((ext_vector_type(4)));
typedef unsigned u32x4 __attribute__((ext_vector_type(4)));
constexpr int BM = 256, BK = 64, HALF = 128, HTB = HALF * BK * 2  , STAGE_BYTES = 8 * HTB, NXCD = 8, WGM = 8;

__host__ __device__ __forceinline__ int lds_byte(int r, int c) { const int st = (r >> 4) * 2 + (c >> 5), rr = r & 15, cc = c & 31, ob = rr * 64 + cc * 2; return st * 1024 + (ob ^ (((ob >> 9) & 1) << 5)); }
__host__ __device__ __forceinline__ void stage_rc(int b, int& R, int& C) { const int st = b / 1024, sb = b % 1024, swz = sb ^ (((sb >> 9) & 1) << 5); R = (st >> 1) * 16 + swz / 64; C = (st & 1) * 32 + (swz % 64) / 2; }
__host__ __device__ __forceinline__ int perm32(int rho) { const int n = rho >> 4, i = rho & 15; return 8 * (i >> 2) + 4 * n + (i & 3); }

struct Unit { int pm, pn, kt0, nkt, aux; };
struct Gemm { const bf16_t* A; const bf16_t* Bt; int M, N, K; int a_blk; };

struct StaticOrder {
    int nM, nN, nwg, G, c, nt;
    __host__ __device__ void init(int M, int N, int K, int G_, int c_) { nM = M / BM; nN = N / BM; nwg = nM * nN; G = G_; c = c_; nt = K / BK; }
    __host__ __device__ bool next(int i, Unit& u) const {
        const long L = (long)i * G + c; if (L >= nwg) return false;
        int wgid = (int)L; { const int q = nwg / NXCD, r = nwg % NXCD, xcd = wgid % NXCD, off = wgid / NXCD; wgid = (xcd < r ? xcd * (q + 1) : r * (q + 1) + (xcd - r) * q) + off; }
        const int nig = WGM * nN, gid = wgid / nig, fm = gid * WGM, gsz = (nM - fm) < WGM ? (nM - fm) : WGM;
        u.pm = fm + ((wgid % nig) % gsz); u.pn = (wgid % nig) / gsz; u.kt0 = 0; u.nkt = nt; u.aux = 0; return true;
    }
    __device__ __forceinline__ void a_ready(const Unit&) const {}
    __device__ __forceinline__ void done(const Unit&) const {}
};
__device__ __forceinline__ unsigned cvt_pk_bf16(float lo, float hi) { unsigned r; asm volatile("v_cvt_pk_bf16_f32 %0, %1, %2" : "=v"(r) : "v"(lo), "v"(hi)); return r; }
template <class Epi, class Sched, bool ALIGN_EPI = false, bool SP2 = false>
__device__ __forceinline__ void gemm_phase(PG8_LAS unsigned char* lds, const Gemm g, const Sched& S, const Epi& E) {
    int tid_ = threadIdx.x; asm volatile("" : "+v"(tid_));
    const int tid = tid_, wid = __builtin_amdgcn_readfirstlane(tid >> 6), lane = tid & 63, wr = wid >> 2, wc = wid & 3, fr = lane & 15, fq = lane >> 4;
    const int K = g.K;
    unsigned voffA[2], voffB[2];
#pragma unroll
    for (int i = 0; i < 2; ++i) { int R, C; stage_rc(tid * 16 + i * 8192, R, C); const int Rb = Epi::PERM ? ((R & ~31) + perm32(R & 31)) : R;
        voffA[i] = (unsigned)(R * (g.a_blk ? BK : K) + C) * 2u; voffB[i] = (unsigned)(Rb * K + C) * 2u; }
    const size_t kstep = (size_t)(BK * 2);
    const size_t hstep = (size_t)HALF * K * 2;
    const size_t tstep = 2 * hstep;
    const size_t kstepA = g.a_blk ? (size_t)(BM * BK * 2) : kstep, hstepA = g.a_blk ? (size_t)(HALF * BK * 2) : hstep;
    const unsigned ldsw = (unsigned)wid * 1024u;
    const int aoff = lds_byte(wr * 64 + fr, fq * 8), boff = lds_byte(wc * 32 + fr, fq * 8);
#define PG8_SA(b, h) (((b) * 2 + (h)) * HTB)
#define PG8_SB(b, h) ((4 + (b) * 2 + (h)) * HTB)
#define PG8_STAGE(bufoff, gbase, voff) do { _Pragma("unroll") for (int _i = 0; _i < 2; ++_i) \
        __builtin_amdgcn_global_load_lds((const unsigned*)((const char*)(gbase) + (voff)[_i]), (PG8_LAS unsigned*)(lds + (bufoff) + ldsw + _i * 8192), 16, 0, 0); } while (0)
#define PG8_LDA(dst, b, h) do { _Pragma("unroll") for (int m = 0; m < 4; ++m) _Pragma("unroll") for (int k = 0; k < 2; ++k) dst[m][k] = *(const PG8_LAS bf16x8*)(lds + PG8_SA(b, h) + aoff + m * 2048 + k * 1024); } while (0)
#define PG8_LDB(dst, b, h) do { _Pragma("unroll") for (int n = 0; n < 2; ++n) _Pragma("unroll") for (int k = 0; k < 2; ++k) dst[n][k] = *(const PG8_LAS bf16x8*)(lds + PG8_SB(b, h) + boff + n * 2048 + k * 1024); } while (0)
#define PG8_MMA(ai, bj, At, Bt) do { __builtin_amdgcn_s_setprio(1); _Pragma("unroll") for (int m = 0; m < 4; ++m) _Pragma("unroll") for (int n = 0; n < 2; ++n) _Pragma("unroll") for (int k = 0; k < 2; ++k) \
        acc[ai][bj][m][n] = __builtin_amdgcn_mfma_f32_16x16x32_bf16(Bt[n][k], At[m][k], acc[ai][bj][m][n], 0, 0, 0); __builtin_amdgcn_s_setprio(0); } while (0)
#define PG8_WAIT_V(n) asm volatile("s_waitcnt vmcnt(" #n ")" ::: "memory")
#define PG8_WAIT_L(n) asm volatile("s_waitcnt lgkmcnt(" #n ")" ::: "memory")
#define PG8_BAR __builtin_amdgcn_s_barrier()
#define PG8_SCHED __builtin_amdgcn_sched_barrier(0)
    Unit cur, nxt; int ui = 0;
    if (!S.next(0, cur)) return;
    f32x4 acc[2][2][4][2];
#pragma unroll
    for (int a = 0; a < 2; ++a)
#pragma unroll
        for (int b = 0; b < 2; ++b)
#pragma unroll
            for (int m = 0; m < 4; ++m)
#pragma unroll
                for (int n = 0; n < 2; ++n) acc[a][b][m][n] = (f32x4){0.f, 0.f, 0.f, 0.f};
    bf16x8 At[4][2], B0[2][2], B1[2][2];
    const char* cA = (const char*)g.A + (size_t)cur.pm * tstep + (size_t)cur.kt0 * kstepA; const char* cB = (const char*)g.Bt + (size_t)cur.pn * tstep + (size_t)cur.kt0 * kstep;
    S.a_ready(cur);
    if constexpr (SP2) {
        PG8_STAGE(PG8_SB(0, 0), cB, voffB); PG8_STAGE(PG8_SB(0, 1), cB + hstep, voffB); PG8_STAGE(PG8_SA(0, 0), cA, voffA); PG8_STAGE(PG8_SA(0, 1), cA + hstepA, voffA);
        if (wr == 1) PG8_BAR;
        PG8_WAIT_V(2); PG8_BAR;
        PG8_STAGE(PG8_SB(1, 0), cB + kstep, voffB); PG8_STAGE(PG8_SA(1, 0), cA + kstepA, voffA); PG8_STAGE(PG8_SB(1, 1), cB + hstep + kstep, voffB);
        PG8_WAIT_V(6); PG8_BAR;
    } else {
        PG8_STAGE(PG8_SB(0, 0), cB, voffB); PG8_STAGE(PG8_SA(0, 0), cA, voffA); PG8_STAGE(PG8_SB(0, 1), cB + hstep, voffB); PG8_STAGE(PG8_SA(0, 1), cA + hstepA, voffA);
        if (wr == 1) PG8_BAR;
        PG8_WAIT_V(4); PG8_BAR;
        PG8_STAGE(PG8_SB(1, 0), cB + kstep, voffB); PG8_STAGE(PG8_SA(1, 0), cA + kstepA, voffA); PG8_STAGE(PG8_SB(1, 1), cB + hstep + kstep, voffB);
        PG8_WAIT_V(6); PG8_BAR;
    }
    for (;;) {
        const bool has_next = S.next(ui + 1, nxt);
        const char* nA = has_next ? (const char*)g.A + (size_t)nxt.pm * tstep + (size_t)nxt.kt0 * kstepA : cA; const char* nB = has_next ? (const char*)g.Bt + (size_t)nxt.pn * tstep + (size_t)nxt.kt0 * kstep : cB;
        const int nt = cur.nkt;
        for (int t = 0; t < nt; t += 2) {
            const bool last = (t == nt - 2);
            const char* a1 = cA + (size_t)(t + 1) * kstepA;
            const char* a2 = last ? nA : cA + (size_t)(t + 2) * kstepA; const char* b2 = last ? nB : cB + (size_t)(t + 2) * kstep;
            const char* a3 = a2 + kstepA; const char* b3 = b2 + kstep;
            if (last && has_next) S.a_ready(nxt);
            if constexpr (SP2) {
            PG8_LDB(B0, 0, 0); PG8_LDB(B1, 0, 1); PG8_SCHED; PG8_LDA(At, 0, 0); PG8_STAGE(PG8_SA(1, 1), a1 + hstepA, voffA);
            PG8_WAIT_V(8); PG8_WAIT_L(0); PG8_BAR; PG8_MMA(0, 0, At, B0); PG8_MMA(0, 1, At, B1); PG8_BAR; PG8_SCHED;
            PG8_LDA(At, 0, 1); PG8_STAGE(PG8_SB(0, 0), b2, voffB); PG8_STAGE(PG8_SB(0, 1), b2 + hstep, voffB); PG8_STAGE(PG8_SA(0, 0), a2, voffA);
            PG8_WAIT_V(8); PG8_WAIT_L(0); PG8_BAR; PG8_MMA(1, 0, At, B0); PG8_MMA(1, 1, At, B1); PG8_BAR; PG8_SCHED;
            PG8_LDB(B0, 1, 0); PG8_LDB(B1, 1, 1); PG8_SCHED; PG8_LDA(At, 1, 0); PG8_STAGE(PG8_SA(0, 1), a2 + hstepA, voffA);
            PG8_WAIT_V(8); PG8_WAIT_L(0); PG8_BAR; PG8_MMA(0, 0, At, B0); PG8_MMA(0, 1, At, B1); PG8_BAR; PG8_SCHED;
            PG8_LDA(At, 1, 1); PG8_STAGE(PG8_SB(1, 0), b3, voffB); PG8_STAGE(PG8_SB(1, 1), b3 + hstep, voffB); PG8_STAGE(PG8_SA(1, 0), a3, voffA);
            PG8_WAIT_V(8); PG8_WAIT_L(0); PG8_BAR; PG8_MMA(1, 0, At, B0); PG8_MMA(1, 1, At, B1); PG8_BAR; PG8_SCHED;
            } else {
            PG8_LDB(B0, 0, 0); PG8_SCHED; PG8_LDA(At, 0, 0); PG8_STAGE(PG8_SA(1, 1), a1 + hstepA, voffA);
            PG8_WAIT_L(8); PG8_BAR; PG8_WAIT_L(0); PG8_MMA(0, 0, At, B0); PG8_BAR; PG8_SCHED;
            PG8_LDB(B1, 0, 1); PG8_STAGE(PG8_SB(0, 0), b2, voffB);
            PG8_BAR; PG8_WAIT_L(0); PG8_MMA(0, 1, At, B1); PG8_BAR;
            PG8_LDA(At, 0, 1); PG8_STAGE(PG8_SA(0, 0), a2, voffA);
            PG8_BAR; PG8_WAIT_L(0); PG8_MMA(1, 0, At, B0); PG8_BAR; PG8_SCHED;
            PG8_STAGE(PG8_SB(0, 1), b2 + hstep, voffB);
            PG8_WAIT_V(6); PG8_BAR; PG8_MMA(1, 1, At, B1); PG8_BAR;
            PG8_LDB(B0, 1, 0); PG8_SCHED; PG8_LDA(At, 1, 0); PG8_STAGE(PG8_SA(0, 1), a2 + hstepA, voffA);
            PG8_WAIT_L(8); PG8_BAR; PG8_WAIT_L(0); PG8_MMA(0, 0, At, B0); PG8_BAR; PG8_SCHED;
            PG8_LDB(B1, 1, 1); PG8_STAGE(PG8_SB(1, 0), b3, voffB);
            PG8_BAR; PG8_WAIT_L(0); PG8_MMA(0, 1, At, B1); PG8_BAR;
            PG8_LDA(At, 1, 1); PG8_STAGE(PG8_SA(1, 0), a3, voffA);
            PG8_BAR; PG8_WAIT_L(0); PG8_MMA(1, 0, At, B0); PG8_BAR; PG8_SCHED;
            PG8_STAGE(PG8_SB(1, 1), b3 + hstep, voffB);
            PG8_WAIT_V(6); PG8_BAR; PG8_MMA(1, 1, At, B1); PG8_BAR;
            }
        }
        if constexpr (ALIGN_EPI) { if (wr == 0) PG8_BAR; }
        if constexpr (!Epi::AFTER_DRAIN) { E(acc, cur, wr, wc, fr, fq); S.done(cur); }
        if (!has_next) break;
#pragma unroll
        for (int a = 0; a < 2; ++a)
#pragma unroll
            for (int b = 0; b < 2; ++b)
#pragma unroll
                for (int m = 0; m < 4; ++m)
#pragma unroll
                    for (int n = 0; n < 2; ++n) acc[a][b][m][n] = (f32x4){0.f, 0.f, 0.f, 0.f};
        cur = nxt; cA = nA; cB = nB; ++ui;
        if constexpr (ALIGN_EPI) { if (wr == 1) PG8_BAR; }
    }
    PG8_WAIT_V(0);
    if constexpr (!ALIGN_EPI) { if (wr == 0) PG8_BAR; }
    PG8_BAR;
    if constexpr (Epi::AFTER_DRAIN) { E.fused(acc, cur, wr, wc, fr, fq, lds, wid, lane); S.done(cur); }
#undef PG8_SA
#undef PG8_SB
#undef PG8_STAGE
#undef PG8_LDA
#undef PG8_LDB
#undef PG8_MMA
#undef PG8_WAIT_V
#undef PG8_WAIT_L
#undef PG8_BAR
#undef PG8_SCHED
}
}

namespace mk {
using pg8::bf16_t; using pg8::bf16x8; using pg8::f32x4; using pg8::u32x4; using pg8::Unit;
#define DI __device__ __forceinline__
#define LAS __attribute__((address_space(3)))
typedef short s16x4 __attribute__((ext_vector_type(4)));
typedef float f32x16 __attribute__((ext_vector_type(16)));
typedef float f32x2 __attribute__((ext_vector_type(2)));
typedef unsigned u32x2 __attribute__((ext_vector_type(2)));
typedef __bf16 bf16x2_t __attribute__((ext_vector_type(2)));
#define MFMA32(a, b, c) __builtin_amdgcn_mfma_f32_32x32x16_bf16((a), (b), (c), 0, 0, 0)

constexpr int MP = 32768, MS = 2048, M = MP + MS, D = 1024, FF = 2816, NUP = 2 * FF, NIN = 3584, NMOD = 9 * D;
constexpr float EPS = 1e-6f, LOG2E = 1.4426950408889634f;
constexpr float QSCALE = 0.18033688011112042f;
constexpr float KSCALE = 0.08838834764831845f;
constexpr float SB_EXIT = 1e-30f;

constexpr size_t MiB = 1u << 20;
constexpr size_t WS_CTL = 0, WS_BAR = 65536, WS_MOD = 1 * MiB, WS_ROPE = 4 * MiB;
constexpr size_t WS_WUP1 = 8 * MiB, WS_WDN1 = 19 * MiB, WS_WIN = 25 * MiB, WS_WOUT = 32 * MiB, WS_WUP2 = 34 * MiB, WS_WDN2 = 45 * MiB;
constexpr size_t WS_XN = 60 * MiB, WS_BIG = 128 * MiB;
constexpr size_t WS_ACT = WS_BIG;
constexpr size_t WS_SBQ = WS_BIG, WS_SBK = WS_BIG + 34 * MiB, WS_SBVT = WS_BIG + 68 * MiB, WS_RQ = WS_BIG + 102 * MiB, WS_RK = WS_BIG + 136 * MiB,
                 WS_RKT = WS_BIG + 170 * MiB, WS_RVT = WS_BIG + 204 * MiB, WS_RG = WS_BIG + 238 * MiB, WS_MIX = WS_XN  , WS_LT = WS_BIG + 272 * MiB, WS_XB = WS_BIG + 288 * MiB, WS_END = WS_BIG + 356 * MiB;
constexpr int NG = 16, CG = 8;
constexpr size_t O_Y = 0, O_KP = 35651584, O_VP = 52428800, O_SP = 69206016, O_KS = 69468160, O_VS = 70516736, O_SS = 71565312;

constexpr int LDS_BYTES = 147456;
#ifndef PH_MASK
#define PH_MASK 0xFFF
#endif
#define PHON(k) ((PH_MASK >> (k)) & 1)
#ifndef PH_REP
#define PH_REP 0
#endif
#ifndef PH_DUP
#define PH_DUP -1
#endif
#define PHREP(k) ((PH_REP >> (k)) & 1)

DI unsigned pk2(float lo, float hi) { f32x2 v = {lo, hi}; bf16x2_t b = __builtin_convertvector(v, bf16x2_t); return __builtin_bit_cast(unsigned, b); }
DI float bf2f(unsigned short s) { return __builtin_bit_cast(float, (unsigned)s << 16); }
DI f32x4 bf4(u32x2 w) { f32x4 r; r[0] = __builtin_bit_cast(float, w.x << 16); r[1] = __builtin_bit_cast(float, w.x & 0xffff0000u); r[2] = __builtin_bit_cast(float, w.y << 16); r[3] = __builtin_bit_cast(float, w.y & 0xffff0000u); return r; }
DI int row_batch(int r) { return r < MP ? (r >> 13) : 4 + ((r - MP) >> 6); }
DI int row_pos(int r) { return r < MP ? (r & 8191) : 2048 + ((r - MP) & 63); }
DI float lg_gamma(int head) { return head == 0 ? -0.04580368961312479f : head == 1 ? -0.02272007650008353f : head == 2 ? -0.011315313227834146f : -0.005646563141142063f; }
DI float ex2(float x) { return __builtin_amdgcn_exp2f(x); }
DI float siluf(float g) { return g * __builtin_amdgcn_rcpf(1.f + ex2(-g * LOG2E)); }
DI float wave_sum(float v) {
#pragma unroll
    for (int o = 1; o < 64; o <<= 1) v += __shfl_xor(v, o);
    return v;
}
DI bf16x8 pack8(const f32x16& x, int s) {
    u32x4 p; p.x = pk2(x[8 * s], x[8 * s + 1]); p.y = pk2(x[8 * s + 2], x[8 * s + 3]); p.z = pk2(x[8 * s + 4], x[8 * s + 5]); p.w = pk2(x[8 * s + 6], x[8 * s + 7]);
    return __builtin_bit_cast(bf16x8, p);
}
DI bf16x8 ld8(const bf16_t* p) { return *(const bf16x8*)p; }
DI bf16x8 ld44(const bf16_t* p, int stride = 8) {
    const s16x4 lo = *(const s16x4*)p, hi = *(const s16x4*)(p + stride);
    return __builtin_shufflevector(lo, hi, 0, 1, 2, 3, 4, 5, 6, 7);
}

DI u32x4 tr8x8(u32x4 w, int lane) {
    { const bool b = (lane & 4) != 0;
      const unsigned s0 = b ? w.x : w.z, s1 = b ? w.y : w.w, r0 = __shfl_xor(s0, 4), r1 = __shfl_xor(s1, 4);
      if (b) { w.x = r0; w.y = r1; } else { w.z = r0; w.w = r1; } }
    { const bool b = (lane & 2) != 0;
      const unsigned s0 = b ? w.x : w.y, s1 = b ? w.z : w.w, r0 = __shfl_xor(s0, 2), r1 = __shfl_xor(s1, 2);
      if (b) { w.x = r0; w.z = r1; } else { w.y = r0; w.w = r1; } }
    { const bool b = (lane & 1) != 0;
      const unsigned p0 = __shfl_xor(w.x, 1), p1 = __shfl_xor(w.y, 1), p2 = __shfl_xor(w.z, 1), p3 = __shfl_xor(w.w, 1);
      if (b) { w.x = (p0 >> 16) | (w.x & 0xffff0000u); w.y = (p1 >> 16) | (w.y & 0xffff0000u); w.z = (p2 >> 16) | (w.z & 0xffff0000u); w.w = (p3 >> 16) | (w.w & 0xffff0000u); }
      else   { w.x = (w.x & 0xffffu) | (p0 << 16); w.y = (w.y & 0xffffu) | (p1 << 16); w.z = (w.z & 0xffffu) | (p2 << 16); w.w = (w.w & 0xffffu) | (p3 << 16); } }
    return w;
}

struct EpiSwiGLU {
    static constexpr bool PERM = true, AFTER_DRAIN = false;
    bf16_t* O;
    DI void operator()(const f32x4 (&acc)[2][2][4][2], const Unit& u, int wr, int wc, int fr, int fq) const {
        asm volatile("" : "+v"(fr), "+v"(fq));
        const int rl0 = wr * 64 + fr, kt = 2 * u.pn + (wc >> 1), cin = 32 * (wc & 1) + 8 * fq;
        bf16_t* blk = O + ((size_t)(u.pm * (FF / 64) + kt) * 256) * 64 + cin;
#pragma unroll
        for (int ai = 0; ai < 2; ++ai)
#pragma unroll
            for (int m = 0; m < 4; ++m) {
                const f32x4 g0 = acc[ai][0][m][0], g1 = acc[ai][0][m][1], u0 = acc[ai][1][m][0], u1 = acc[ai][1][m][1];
                u32x4 w;
                w.x = pk2(siluf(g0[0]) * u0[0], siluf(g0[1]) * u0[1]); w.y = pk2(siluf(g0[2]) * u0[2], siluf(g0[3]) * u0[3]);
                w.z = pk2(siluf(g1[0]) * u1[0], siluf(g1[1]) * u1[1]); w.w = pk2(siluf(g1[2]) * u1[2], siluf(g1[3]) * u1[3]);
                *(u32x4*)(blk + (size_t)(rl0 + ai * 128 + m * 16) * 64) = w;
            }
    }
};
struct EpiResid {
    static constexpr bool PERM = false, AFTER_DRAIN = false;
    const float* baseP; const float* baseS; float* out; const float* mod; int gofs; float gscale; int mode;
    DI void operator()(const f32x4 (&acc)[2][2][4][2], const Unit& u, int wr, int wc, int fr, int fq) const {
        asm volatile("" : "+v"(fr), "+v"(fq));
        const int row0 = u.pm * 256 + wr * 64 + fr, col0 = u.pn * 256 + wc * 32 + 4 * fq;
        bf16_t* xb = (bf16_t*)((unsigned char*)const_cast<float*>(mod) + (WS_XB - WS_MOD));
#pragma unroll
        for (int ai = 0; ai < 2; ++ai) {
            const float* mb = mod + (size_t)row_batch(u.pm * 256 + ai * 128 + wr * 64) * NMOD + gofs;
            f32x4 gv[2][2];
#pragma unroll
            for (int bj = 0; bj < 2; ++bj)
#pragma unroll
                for (int n = 0; n < 2; ++n) gv[bj][n] = *(const f32x4*)(mb + col0 + bj * 128 + n * 16) * gscale;
#pragma unroll
            for (int m = 0; m < 4; ++m) {
                const int row = row0 + ai * 128 + m * 16;
                f32x4 bv[2][2];
                if (mode == 0) {
                    const float* bp = row < MP ? baseP + (size_t)row * D : baseS + (size_t)(row - MP) * D;
#pragma unroll
                    for (int bj = 0; bj < 2; ++bj)
#pragma unroll
                        for (int n = 0; n < 2; ++n) bv[bj][n] = *(const f32x4*)(bp + col0 + bj * 128 + n * 16);
                } else {
#pragma unroll
                    for (int bj = 0; bj < 2; ++bj)
#pragma unroll
                        for (int n = 0; n < 2; ++n) bv[bj][n] = bf4(*(const u32x2*)(xb + (size_t)row * D + col0 + bj * 128 + n * 16));
                }
#pragma unroll
                for (int bj = 0; bj < 2; ++bj)
#pragma unroll
                    for (int n = 0; n < 2; ++n) {
                        const f32x4 o = bv[bj][n] + gv[bj][n] * acc[ai][bj][m][n];
                        if (mode == 2) *(f32x4*)(out + (size_t)row * D + col0 + bj * 128 + n * 16) = o;
                        else { u32x2 w; w.x = pk2(o[0], o[1]); w.y = pk2(o[2], o[3]); *(u32x2*)(xb + (size_t)row * D + col0 + bj * 128 + n * 16) = w; }
                    }
            }
        }
    }
};
struct EpiIn {
    static constexpr bool PERM = true, AFTER_DRAIN = false;
    const float* gq; const float* gk; const f32x2* tab;
    float* outf;
    unsigned char* ws;
    DI void operator()(const f32x4 (&acc)[2][2][4][2], const Unit& u, int wr, int wc, int fr, int fq) const {
        asm volatile("" : "+v"(fr), "+v"(fq));
        const int pn = u.pn, rbase = u.pm * 256 + wr * 64 + fr, e0 = 8 * fq;
        if (pn < 4) {
            const bool isk = pn >= 2; const int head = 4 * (pn & 1) + wc;
            const float* gain = isk ? gk : gq;
            f32x4 gv[2][2];
#pragma unroll
            for (int bj = 0; bj < 2; ++bj)
#pragma unroll
                for (int n = 0; n < 2; ++n) gv[bj][n] = *(const f32x4*)(gain + 32 * bj + e0 + 4 * n);
            bf16_t* ob = (bf16_t*)(ws + (isk ? WS_SBK : WS_SBQ));
#pragma unroll
            for (int ai = 0; ai < 2; ++ai)
#pragma unroll
                for (int m = 0; m < 4; ++m) {
                    const int row = rbase + ai * 128 + m * 16;
                    float ss = 0.f;
#pragma unroll
                    for (int bj = 0; bj < 2; ++bj)
#pragma unroll
                        for (int n = 0; n < 2; ++n) { const f32x4 x = acc[ai][bj][m][n]; ss += (x[0] * x[0] + x[1] * x[1]) + (x[2] * x[2] + x[3] * x[3]); }
                    ss += __shfl_xor(ss, 16); ss += __shfl_xor(ss, 32);
                    float inv = __builtin_amdgcn_rsqf(ss * (1.f / 64.f) + EPS);
                    const float invq = isk ? inv : inv * QSCALE;
#pragma unroll
                    for (int bj = 0; bj < 2; ++bj) {
                        const f32x4 v0 = acc[ai][bj][m][0] * gv[bj][0], v1 = acc[ai][bj][m][1] * gv[bj][1];
                        const f32x4 w0 = v0 * invq, w1 = v1 * invq;
                        u32x4 w; w.x = pk2(w0[0], w0[1]); w.y = pk2(w0[2], w0[3]); w.z = pk2(w1[0], w1[1]); w.w = pk2(w1[2], w1[3]);
                        *(u32x4*)(ob + (size_t)row * 512 + head * 64 + 32 * bj + e0) = w;
                        if (isk) {
                            float* o = (row < MP ? outf + O_KP + (size_t)row * 512 : outf + O_KS + (size_t)(row - MP) * 512) + head * 64 + 32 * bj + e0;
                            *(f32x4*)o = w0; *(f32x4*)(o + 4) = w1;
                        }
                    }
                }
        } else if (pn < 6) {
            const int head = 4 * (pn - 4) + wc;
            bf16_t* vt = (bf16_t*)(ws + WS_SBVT);
#pragma unroll
            for (int ai = 0; ai < 2; ++ai)
#pragma unroll
                for (int m = 0; m < 4; ++m) {
                    const int row = rbase + ai * 128 + m * 16;
                    float* o = (row < MP ? outf + O_VP + (size_t)row * 512 : outf + O_VS + (size_t)(row - MP) * 512) + head * 64 + e0;
                    bf16_t* t = vt + (((size_t)((row >> 5) * 8 + head) * 4 + ((row >> 3) & 3)) * 64 + e0 + (fr & 7)) * 8;
#pragma unroll
                    for (int bj = 0; bj < 2; ++bj) {
                        const f32x4 x0 = acc[ai][bj][m][0], x1 = acc[ai][bj][m][1];
                        *(f32x4*)(o + 32 * bj) = x0; *(f32x4*)(o + 32 * bj + 4) = x1;
                        u32x4 w; w.x = pk2(x0[0], x0[1]); w.y = pk2(x0[2], x0[3]); w.z = pk2(x1[0], x1[1]); w.w = pk2(x1[2], x1[3]);
                        *(u32x4*)(t + 32 * bj * 8) = tr8x8(w, fr);
                    }
                }
        } else {
            const int q = pn - 6, kind = q >> 1, head = 2 * (q & 1) + (wc >> 1), f0 = 32 * (wc & 1) + e0;
            const float lg = lg_gamma(head);
            if (kind <= 1) {
                bf16_t* ob = (bf16_t*)(ws + (kind ? WS_RK : WS_RQ));
                bf16_t* kt = (bf16_t*)(ws + WS_RKT);
#pragma unroll
                for (int ai = 0; ai < 2; ++ai)
#pragma unroll
                    for (int m = 0; m < 4; ++m) {
                        asm volatile("" ::: "memory");
                        const int row = rbase + ai * 128 + m * 16, pos = row_pos(row), ic = pos & 63;
                        const float sc = kind ? KSCALE * ex2(-(float)ic * lg) : ex2((float)ic * lg);
                        const f32x4* tp = (const f32x4*)(tab + (size_t)pos * 64 + f0);
                        f32x4 o1[2], o2[2];
#pragma unroll
                        for (int n = 0; n < 2; ++n) {
                            const f32x4 t0 = tp[2 * n], t1 = tp[2 * n + 1];
                            const f32x4 x1 = acc[ai][0][m][n], x2 = acc[ai][1][m][n];
                            const f32x4 cc = {t0[0], t0[2], t1[0], t1[2]}, sn = {t0[1], t0[3], t1[1], t1[3]};
                            o1[n] = (x1 * cc - x2 * sn) * sc; o2[n] = (x1 * sn + x2 * cc) * sc;
                        }
                        u32x4 w1, w2;
                        w1.x = pk2(o1[0][0], o1[0][1]); w1.y = pk2(o1[0][2], o1[0][3]); w1.z = pk2(o1[1][0], o1[1][1]); w1.w = pk2(o1[1][2], o1[1][3]);
                        w2.x = pk2(o2[0][0], o2[0][1]); w2.y = pk2(o2[0][2], o2[0][3]); w2.z = pk2(o2[1][0], o2[1][1]); w2.w = pk2(o2[1][2], o2[1][3]);
                        bf16_t* p = ob + (size_t)row * 512 + head * 128 + f0;
                        *(u32x4*)p = w1; *(u32x4*)(p + 64) = w2;
                        asm volatile("" ::: "memory");
                        if (kind) {
                            bf16_t* t = kt + (((size_t)((row >> 6) * 4 + head) * 8 + ((row >> 3) & 7)) * 128 + f0 + (fr & 7)) * 8;
                            *(u32x4*)t = tr8x8(w1, fr); *(u32x4*)(t + 64 * 8) = tr8x8(w2, fr);
                        }
                    }
            } else if (kind == 2) {
                bf16_t* vt = (bf16_t*)(ws + WS_RVT);
#pragma unroll
                for (int ai = 0; ai < 2; ++ai)
#pragma unroll
                    for (int m = 0; m < 4; ++m) {
                        const int row = rbase + ai * 128 + m * 16;
                        bf16_t* t = vt + (((size_t)((row >> 6) * 4 + head) * 8 + ((row >> 3) & 7)) * 128 + f0 + (fr & 7)) * 8;
#pragma unroll
                        for (int bj = 0; bj < 2; ++bj) {
                            const f32x4 x0 = acc[ai][bj][m][0], x1 = acc[ai][bj][m][1];
                            u32x4 w; w.x = pk2(x0[0], x0[1]); w.y = pk2(x0[2], x0[3]); w.z = pk2(x1[0], x1[1]); w.w = pk2(x1[2], x1[3]);
                            *(u32x4*)(t + 64 * bj * 8) = tr8x8(w, fr);
                        }
                    }
            } else {
                bf16_t* ob = (bf16_t*)(ws + WS_RG);
#pragma unroll
                for (int ai = 0; ai < 2; ++ai)
#pragma unroll
                    for (int m = 0; m < 4; ++m) {
                        const int row = rbase + ai * 128 + m * 16;
#pragma unroll
                        for (int bj = 0; bj < 2; ++bj) {
                            const f32x4 x0 = acc[ai][bj][m][0], x1 = acc[ai][bj][m][1];
                            u32x4 w; w.x = pk2(siluf(x0[0]), siluf(x0[1])); w.y = pk2(siluf(x0[2]), siluf(x0[3])); w.z = pk2(siluf(x1[0]), siluf(x1[1])); w.w = pk2(siluf(x1[2]), siluf(x1[3]));
                            *(u32x4*)(ob + (size_t)row * 512 + head * 128 + 64 * bj + f0) = w;
                        }
                    }
            }
        }
    }
};

DI int srccol_in(int cp) {
    const int pn = cp >> 8, loc = cp & 255, bj = loc >> 7, wc = (loc & 127) >> 5;
    if (pn < 6) { const int seg = pn >> 1, pp = pn & 1; return seg * 512 + 64 * (4 * pp + wc) + 32 * bj; }
    const int q = pn - 6, seg = q >> 1, pp = q & 1; return 1536 + seg * 512 + 128 * (2 * pp + (wc >> 1)) + 64 * bj + 32 * (wc & 1);
}
DI int srccol_up(int cp) { const int pn = cp >> 8, bj = (cp >> 7) & 1, i = cp & 127; return bj * FF + 128 * pn + i; }

DI void p0_transpose_item(const float* W, int K, int N, int srcc, bf16_t* WT, int dstr, int k0, LAS float* scr, int lane) {
#pragma unroll 8
    for (int i = 0; i < 32; ++i) { const int kk = 2 * i + (lane >> 5); scr[kk * 33 + (lane & 31)] = W[(size_t)(k0 + kk) * N + srcc + (lane & 31)]; }
    asm volatile("s_waitcnt lgkmcnt(0)" ::: "memory");
    const int c = lane & 7;
#pragma unroll
    for (int j = 0; j < 4; ++j) { const int n = (lane >> 3) + 8 * j; const LAS float* s = scr + (8 * c) * 33 + n;
        u32x4 o; o.x = pk2(s[0 * 33], s[1 * 33]); o.y = pk2(s[2 * 33], s[3 * 33]); o.z = pk2(s[4 * 33], s[5 * 33]); o.w = pk2(s[6 * 33], s[7 * 33]);
        *(u32x4*)(WT + (size_t)(dstr + n) * K + k0 + 8 * c) = o; }
    asm volatile("s_waitcnt lgkmcnt(0)" ::: "memory");
}
DI void ada_item(int it, const float* cP, const float* cS, const float* wada, const float* bada, float* mod, LAS float* red, int tid, int wave, int lane) {
    const int c0 = it * 64;
    LAS float* cs = red + wave * (64 * 36);
    float acc[36];
#pragma unroll
    for (int b = 0; b < 36; ++b) acc[b] = 0.f;
#pragma unroll 1
    for (int u = 0; u < 2; ++u) {
        const int kb = 128 * wave + 64 * u;
#pragma unroll 4
        for (int b = 0; b < 36; ++b) { const float cv = b < 4 ? cP[b * 1024 + kb + lane] : cS[(b - 4) * 1024 + kb + lane]; cs[lane * 36 + b] = cv / (1.f + __expf(-cv)); }
        asm volatile("s_waitcnt lgkmcnt(0)" ::: "memory");
#pragma unroll 1
        for (int k8 = 0; k8 < 8; ++k8) {
            float wv[8];
#pragma unroll
            for (int j = 0; j < 8; ++j) wv[j] = wada[(size_t)(kb + 8 * k8 + j) * NMOD + c0 + lane];
#pragma unroll
            for (int j = 0; j < 8; ++j) {
                const LAS f32x4* cr = (const LAS f32x4*)(cs + (8 * k8 + j) * 36);
#pragma unroll
                for (int q = 0; q < 9; ++q) { const f32x4 c4 = cr[q]; acc[4 * q] += c4[0] * wv[j]; acc[4 * q + 1] += c4[1] * wv[j]; acc[4 * q + 2] += c4[2] * wv[j]; acc[4 * q + 3] += c4[3] * wv[j]; }
            }
        }
        asm volatile("s_waitcnt lgkmcnt(0)" ::: "memory");
    }
    __syncthreads();
#pragma unroll
    for (int b = 0; b < 36; ++b) red[(wave * 36 + b) * 64 + lane] = acc[b];
    __syncthreads();
    for (int o = tid; o < 36 * 64; o += 512) {
        const int b = o >> 6, l = o & 63; float s = 0.f;
#pragma unroll
        for (int w = 0; w < 8; ++w) s += red[(w * 36 + b) * 64 + l];
        mod[(size_t)b * NMOD + c0 + l] = s + bada[c0 + l];
    }
    __syncthreads();
}

struct Args {
    const float* in[20]; float* out; unsigned char* ws;
};

DI void p0_prologue(const Args& a, LAS unsigned char* lds, int tid, int wave, int lane, bool first) {
    unsigned char* ws = a.ws;
    if (blockIdx.x == 0 && first) { for (int i = tid; i < 8192; i += 512) ((unsigned*)(ws + WS_CTL))[i] = 0u; for (int i = tid; i < 4096; i += 512) ((unsigned*)(ws + WS_BAR))[i] = 0u; }
    for (int it = blockIdx.x; it < NMOD / 64; it += gridDim.x)
        ada_item(it, a.in[5], a.in[6], a.in[7], a.in[8], (float*)(ws + WS_MOD), (LAS float*)lds, tid, wave, lane);
    for (int idx = blockIdx.x * 512 + tid; idx < 8192 * 64; idx += gridDim.x * 512) {
        const int pos = idx >> 6, f = idx & 63;
        const double xd = -(double)f * 0.20762050593046014; const double nf = __builtin_floor(xd);
        const float fr = (float)(xd - nf);
        const float ifr = __builtin_ldexpf(ex2(fr), (int)nf);
        const double rev = (double)pos * (double)ifr * 0.15915494309189535; const float frac = (float)(rev - __builtin_floor(rev));
        f32x2 cs; cs.x = __builtin_amdgcn_cosf(frac); cs.y = __builtin_amdgcn_sinf(frac);
        ((f32x2*)(ws + WS_ROPE))[idx] = cs;
    }
    LAS float* scr = (LAS float*)(lds + wave * 16384);
    const int gw = blockIdx.x * 8 + wave, NGW = gridDim.x * 8;
    constexpr int I_UP = (D / 64) * (NUP / 32), I_DN = (FF / 64) * (D / 32), I_IN = (D / 64) * (NIN / 32), I_OUT = (D / 64) * (D / 32);
    constexpr int NITEMS = 2 * I_UP + 2 * I_DN + I_IN + I_OUT;
    for (int it = gw; it < NITEMS; it += NGW) {
        int r = it;
        if (r < 2 * I_UP) { const int which = r >= I_UP; r -= which * I_UP; const int nb = r % (NUP / 32), kb = r / (NUP / 32);
            p0_transpose_item(a.in[which ? 18 : 12], D, NUP, srccol_up(32 * nb), (bf16_t*)(ws + (which ? WS_WUP2 : WS_WUP1)), 32 * nb, 64 * kb, scr, lane); continue; }
        r -= 2 * I_UP;
        if (r < 2 * I_DN) { const int which = r >= I_DN; r -= which * I_DN; const int nb = r % (D / 32), kb = r / (D / 32);
            p0_transpose_item(a.in[which ? 19 : 13], FF, D, 32 * nb, (bf16_t*)(ws + (which ? WS_WDN2 : WS_WDN1)), 32 * nb, 64 * kb, scr, lane); continue; }
        r -= 2 * I_DN;
        if (r < I_IN) { const int nb = r % (NIN / 32), kb = r / (NIN / 32);
            p0_transpose_item(a.in[14], D, NIN, srccol_in(32 * nb), (bf16_t*)(ws + WS_WIN), 32 * nb, 64 * kb, scr, lane); continue; }
        r -= I_IN;
        { const int nb = r % (D / 32), kb = r / (D / 32);
            p0_transpose_item(a.in[17], D, D, 32 * nb, (bf16_t*)(ws + WS_WOUT), 32 * nb, 64 * kb, scr, lane); }
    }
}

DI void norm_finish(int m, const f32x4 (&v)[4], float s, const float* gain, const float* mod, int shofs, int scofs, bf16_t* XN, int lane) {
    const float* mb = mod + (size_t)row_batch(m) * NMOD;
    const float inv = __builtin_amdgcn_rsqf(s * (1.f / D) + EPS);
    u32x2* o8 = (u32x2*)(XN + (size_t)m * D) + lane;
#pragma unroll
    for (int j = 0; j < 4; ++j) {
        const int c = 4 * (64 * j + lane);
        const f32x4 g4 = *(const f32x4*)(gain + c), sc4 = *(const f32x4*)(mb + scofs + c), sh4 = *(const f32x4*)(mb + shofs + c);
        const f32x4 o = v[j] * inv * g4 * (sc4 + 1.f) + sh4;
        u32x2 w; w.x = pk2(o[0], o[1]); w.y = pk2(o[2], o[3]); o8[64 * j] = w;
    }
}
DI void norm_phase(const float* srcP, const float* srcS, const bf16_t* srcB, const float* gain, const float* mod, int shofs, int scofs, bf16_t* XN, int wave, int lane) {
    const int gw = blockIdx.x * 8 + wave, NGW = gridDim.x * 8;
    for (int m = gw; m < M; m += 2 * NGW) {
        const int m2 = m + NGW; const bool two = m2 < M; const int mb2 = two ? m2 : m;
        const f32x4* xa = (const f32x4*)(m < MP ? srcP + (size_t)m * D : srcS + (size_t)(m - MP) * D) + lane;
        const f32x4* xb = (const f32x4*)(mb2 < MP ? srcP + (size_t)mb2 * D : srcS + (size_t)(mb2 - MP) * D) + lane;
        f32x4 va[4], vb[4]; float sa = 0.f, sb = 0.f;
        if (srcB) {
            const u32x2* ba = (const u32x2*)(srcB + (size_t)m * D) + lane; const u32x2* bb = (const u32x2*)(srcB + (size_t)mb2 * D) + lane;
#pragma unroll
            for (int j = 0; j < 4; ++j) { va[j] = bf4(ba[64 * j]); vb[j] = bf4(bb[64 * j]); }
        } else {
#pragma unroll
            for (int j = 0; j < 4; ++j) { va[j] = xa[64 * j]; vb[j] = xb[64 * j]; }
        }
#pragma unroll
        for (int j = 0; j < 4; ++j) { sa += (va[j][0] * va[j][0] + va[j][1] * va[j][1]) + (va[j][2] * va[j][2] + va[j][3] * va[j][3]); sb += (vb[j][0] * vb[j][0] + vb[j][1] * vb[j][1]) + (vb[j][2] * vb[j][2] + vb[j][3] * vb[j][3]); }
#pragma unroll
        for (int o = 1; o < 64; o <<= 1) { sa += __shfl_xor(sa, o); sb += __shfl_xor(sb, o); }
        norm_finish(m, va, sa, gain, mod, shofs, scofs, XN, lane);
        if (two) norm_finish(m2, vb, sb, gain, mod, shofs, scofs, XN, lane);
    }
}

DI void sb_tile(f32x16& O0, f32x16& O1, float& carry, const bf16x8 (&qf)[4], const bf16x8 (&kf)[4], const bf16x8 (&vf)[2][2], bool diag, int lane) {
    f32x16 S;
#pragma unroll
    for (int i = 0; i < 16; ++i) S[i] = 0.f;
#pragma unroll
    for (int ks = 0; ks < 4; ++ks) S = MFMA32(kf[ks], qf[ks], S);
    const int h = lane >> 5, qn = lane & 31;
    float beta[16], ein[16], G[4];
#pragma unroll
    for (int g = 0; g < 4; ++g) {
        float av[4];
#pragma unroll
        for (int r = 0; r < 4; ++r) {
            const int i = 4 * g + r;
            const float z = __builtin_fmaxf(S[i], -100.f);
            const float t = ex2(-z);
            float b = __builtin_amdgcn_rcpf(1.f + t), a = t * b;
            if (diag) { const bool ok = (8 * g + 4 * h + r) < qn; b = ok ? b : 0.f; a = ok ? a : 1.f; }
            beta[i] = b; av[r] = a;
        }
        ein[4 * g + 3] = 1.f; ein[4 * g + 2] = av[3]; ein[4 * g + 1] = av[3] * av[2]; ein[4 * g] = ein[4 * g + 1] * av[1]; G[g] = ein[4 * g] * av[0];
    }
    float Go[4], PP[4], later[4];
#pragma unroll
    for (int g = 0; g < 4; ++g) { Go[g] = __shfl_xor(G[g], 32); PP[g] = G[g] * Go[g]; }
    later[3] = carry; later[2] = later[3] * PP[3]; later[1] = later[2] * PP[2]; later[0] = later[1] * PP[1];
    carry = later[0] * PP[0];
    f32x16 W;
#pragma unroll
    for (int g = 0; g < 4; ++g) {
        const float lt = later[g] * (h == 0 ? Go[g] : 1.f);
#pragma unroll
        for (int r = 0; r < 4; ++r) W[4 * g + r] = beta[4 * g + r] * ein[4 * g + r] * lt;
    }
#pragma unroll
    for (int s = 0; s < 2; ++s) { const bf16x8 wb = pack8(W, s); O0 = MFMA32(vf[0][s], wb, O0); O1 = MFMA32(vf[1][s], wb, O1); }
}
DI void sb_item(int item, const Args& a, int lane) {
    unsigned char* ws = a.ws;
    const bf16_t* SBQ = (const bf16_t*)(ws + WS_SBQ); const bf16_t* SBK = (const bf16_t*)(ws + WS_SBK); const bf16_t* SBVT = (const bf16_t*)(ws + WS_SBVT);
    bf16_t* MIX = (bf16_t*)(ws + WS_MIX);
    const int head = item & 7, gt = item >> 3, row0 = gt * 32, h = lane >> 5, ln = lane & 31;
    bf16x8 qf[4];
#pragma unroll
    for (int ks = 0; ks < 4; ++ks) qf[ks] = ld8(SBQ + (size_t)(row0 + ln) * 512 + head * 64 + 16 * ks + 8 * h);
    f32x16 O0, O1;
#pragma unroll
    for (int i = 0; i < 16; ++i) { O0[i] = 0.f; O1[i] = 0.f; }
    float carry = 1.f;
    const bool prompt = row0 < MP;
    const int gt_last = prompt ? (gt & ~255) : (gt & ~1);
    bool done = false;
    {
        bf16x8 kf[4], vf[2][2];
#pragma unroll
        for (int ks = 0; ks < 4; ++ks) kf[ks] = ld8(SBK + (size_t)(gt * 32 + ln) * 512 + head * 64 + 16 * ks + 8 * h);
#pragma unroll
        for (int ds = 0; ds < 2; ++ds)
#pragma unroll
            for (int s = 0; s < 2; ++s) vf[ds][s] = ld44(SBVT + (((size_t)(gt * 8 + head) * 4 + 2 * s) * 64 + 32 * ds + ln) * 8 + 4 * h, 512);
        for (int kt = gt;; --kt) {
            const bool more = kt > gt_last;
            bf16x8 kn[4], vn[2][2];
            const int kp = more ? kt - 1 : kt;
#pragma unroll
            for (int ks = 0; ks < 4; ++ks) kn[ks] = ld8(SBK + (size_t)(kp * 32 + ln) * 512 + head * 64 + 16 * ks + 8 * h);
#pragma unroll
            for (int ds = 0; ds < 2; ++ds)
#pragma unroll
                for (int s = 0; s < 2; ++s) vn[ds][s] = ld44(SBVT + (((size_t)(kp * 8 + head) * 4 + 2 * s) * 64 + 32 * ds + ln) * 8 + 4 * h, 512);
            __builtin_amdgcn_sched_barrier(0);
            sb_tile(O0, O1, carry, qf, kf, vf, kt == gt, lane);
            asm volatile("" :: "v"(kn[0]), "v"(kn[1]), "v"(kn[2]), "v"(kn[3]), "v"(vn[0][0]), "v"(vn[0][1]), "v"(vn[1][0]), "v"(vn[1][1]));
            if (__all(carry < SB_EXIT)) { done = true; break; }
            if (!more) break;
#pragma unroll
            for (int ks = 0; ks < 4; ++ks) kf[ks] = kn[ks];
#pragma unroll
            for (int ds = 0; ds < 2; ++ds)
#pragma unroll
                for (int s = 0; s < 2; ++s) vf[ds][s] = vn[ds][s];
        }
    }
    if (!prompt && !done) {
        const int bs = (row0 - MP) >> 6;
        const float* ck = a.in[2] + (size_t)bs * 2048 * 512 + head * 64;
        const float* cv = a.in[3] + (size_t)bs * 2048 * 512 + head * 64;
        for (int t0 = 2048 - 32; t0 >= 0; t0 -= 32) {
            bf16x8 kf[4], vf[2][2];
#pragma unroll
            for (int ks = 0; ks < 4; ++ks) {
                const f32x4* p = (const f32x4*)(ck + (size_t)(t0 + ln) * 512 + 16 * ks + 8 * h);
                const f32x4 x0 = p[0], x1 = p[1];
                u32x4 w; w.x = pk2(x0[0], x0[1]); w.y = pk2(x0[2], x0[3]); w.z = pk2(x1[0], x1[1]); w.w = pk2(x1[2], x1[3]);
                kf[ks] = __builtin_bit_cast(bf16x8, w);
            }
#pragma unroll
            for (int ds = 0; ds < 2; ++ds)
#pragma unroll
                for (int s = 0; s < 2; ++s) {
                    float x[8];
#pragma unroll
                    for (int j = 0; j < 8; ++j) x[j] = cv[(size_t)(t0 + 16 * s + 8 * (j >> 2) + 4 * h + (j & 3)) * 512 + 32 * ds + ln];
                    u32x4 w; w.x = pk2(x[0], x[1]); w.y = pk2(x[2], x[3]); w.z = pk2(x[4], x[5]); w.w = pk2(x[6], x[7]);
                    vf[ds][s] = __builtin_bit_cast(bf16x8, w);
                }
            sb_tile(O0, O1, carry, qf, kf, vf, false, lane);
            if (__all(carry < SB_EXIT)) break;
        }
    }
    bf16_t* op = MIX + (size_t)(row0 + ln) * D + head * 64 + 4 * h;
#pragma unroll
    for (int g = 0; g < 4; ++g) {
        u32x2 w0, w1; w0.x = pk2(O0[4 * g], O0[4 * g + 1]); w0.y = pk2(O0[4 * g + 2], O0[4 * g + 3]); w1.x = pk2(O1[4 * g], O1[4 * g + 1]); w1.y = pk2(O1[4 * g + 2], O1[4 * g + 3]);
        *(u32x2*)(op + 8 * g) = w0; *(u32x2*)(op + 32 + 8 * g) = w1;
    }
}

DI void ret_update(f32x16 (&T)[4], const bf16_t* kt, const bf16_t* vt, float c, int slice, int lane) {
    const int h = lane >> 5, ln = lane & 31;
    bf16x8 vfr[4];
#pragma unroll
    for (int ks = 0; ks < 4; ++ks) vfr[ks] = ld8(vt + ((size_t)(2 * ks + h) * 128 + 32 * slice + ln) * 8);
#pragma unroll
    for (int ms = 0; ms < 4; ++ms) {
        T[ms] = T[ms] * c;
#pragma unroll
        for (int ks = 0; ks < 4; ++ks) T[ms] = MFMA32(ld8(kt + ((size_t)(2 * ks + h) * 128 + 32 * ms + ln) * 8), vfr[ks], T[ms]);
    }
}
DI void ret_loadA(bf16x8 (&kfr)[4][4], bf16x8 (&vfr)[4], const bf16_t* kt, const bf16_t* vt, int slice, int lane) {
    const int h = lane >> 5, ln = lane & 31;
#pragma unroll
    for (int ks = 0; ks < 4; ++ks) vfr[ks] = ld8(vt + ((size_t)(2 * ks + h) * 128 + 32 * slice + ln) * 8);
#pragma unroll
    for (int ms = 0; ms < 4; ++ms)
#pragma unroll
        for (int ks = 0; ks < 4; ++ks) kfr[ms][ks] = ld8(kt + ((size_t)(2 * ks + h) * 128 + 32 * ms + ln) * 8);
}
DI void ret_passA(int item, unsigned char* ws, int lane) {
    const int slice = item & 3, g = (item >> 2) % (NG - 1), bh = item / (4 * (NG - 1)), b = bh >> 2, head = bh & 3;
    const float c = ex2(64.f * lg_gamma(head));
    f32x16 T[4];
#pragma unroll
    for (int ms = 0; ms < 4; ++ms)
#pragma unroll
        for (int i = 0; i < 16; ++i) T[ms][i] = 0.f;
    const size_t cg0 = (size_t)(b * 128 + g * CG);
    const bf16_t* KT = (const bf16_t*)(ws + WS_RKT); const bf16_t* VT = (const bf16_t*)(ws + WS_RVT);
    bf16x8 kfr[4][4], vfr[4];
    ret_loadA(kfr, vfr, KT + (cg0 * 4 + head) * 8192, VT + (cg0 * 4 + head) * 8192, slice, lane);
    for (int step = 0; step < CG; ++step) {
        bf16x8 kn[4][4], vn[4];
        const size_t cgn = cg0 + (step < CG - 1 ? step + 1 : step);
        ret_loadA(kn, vn, KT + (cgn * 4 + head) * 8192, VT + (cgn * 4 + head) * 8192, slice, lane);
#pragma unroll
        for (int ms = 0; ms < 4; ++ms) {
            T[ms] = T[ms] * c;
#pragma unroll
            for (int ks = 0; ks < 4; ++ks) T[ms] = MFMA32(kfr[ms][ks], vfr[ks], T[ms]);
        }
#pragma unroll
        for (int ks = 0; ks < 4; ++ks) { vfr[ks] = vn[ks];
#pragma unroll
            for (int ms = 0; ms < 4; ++ms) kfr[ms][ks] = kn[ms][ks]; }
    }
    float* o = (float*)(ws + WS_LT) + (size_t)item * 4096;
#pragma unroll
    for (int ms = 0; ms < 4; ++ms)
#pragma unroll
        for (int i = 0; i < 16; ++i) o[(ms * 16 + i) * 64 + lane] = T[ms][i];
}
constexpr int RB_Q = 0, RB_K = 17408, RB_KT = 34816, RB_VT = 51200, RB_BYTES = 67584, RB_ROW = 272, RB_STATS = 2 * RB_BYTES;
DI bf16x8 lds8(const LAS unsigned char* p) { return *(const LAS bf16x8*)p; }
DI bf16x8 lds44(const LAS unsigned char* p, int stride_bytes) {
    const s16x4 lo = *(const LAS s16x4*)p, hi = *(const LAS s16x4*)(p + stride_bytes);
    return __builtin_shufflevector(lo, hi, 0, 1, 2, 3, 4, 5, 6, 7);
}
DI void ret_stage_load(u32x4 (&r)[16], const bf16_t* RQ, const bf16_t* RK, const bf16_t* kt, const bf16_t* vt, int rc, int head, int t) {
#pragma unroll
    for (int i = 0; i < 4; ++i) { const int q = t + 256 * i; r[i] = *(const u32x4*)(RQ + (size_t)(rc + (q >> 4)) * 512 + head * 128 + (q & 15) * 8); }
#pragma unroll
    for (int i = 0; i < 4; ++i) { const int q = t + 256 * i; r[4 + i] = *(const u32x4*)(RK + (size_t)(rc + (q >> 4)) * 512 + head * 128 + (q & 15) * 8); }
#pragma unroll
    for (int i = 0; i < 4; ++i) { const int q = t + 256 * i; r[8 + i] = *(const u32x4*)(kt + (size_t)q * 8); }
#pragma unroll
    for (int i = 0; i < 4; ++i) { const int q = t + 256 * i; r[12 + i] = *(const u32x4*)(vt + (size_t)q * 8); }
}
DI void ret_stage_store(const u32x4 (&r)[16], LAS unsigned char* buf, int t) {
#pragma unroll
    for (int i = 0; i < 4; ++i) { const int q = t + 256 * i; *(LAS u32x4*)(buf + RB_Q + (q >> 4) * RB_ROW + (q & 15) * 16) = r[i]; }
#pragma unroll
    for (int i = 0; i < 4; ++i) { const int q = t + 256 * i; *(LAS u32x4*)(buf + RB_K + (q >> 4) * RB_ROW + (q & 15) * 16) = r[4 + i]; }
#pragma unroll
    for (int i = 0; i < 4; ++i) { const int q = t + 256 * i; *(LAS u32x4*)(buf + RB_KT + q * 16) = r[8 + i]; }
#pragma unroll
    for (int i = 0; i < 4; ++i) { const int q = t + 256 * i; *(LAS u32x4*)(buf + RB_VT + q * 16) = r[12 + i]; }
}
DI void ret_block(int mode, int ci, const Args& a, LAS unsigned char* lds, int tid, int wave, int lane) {
    unsigned char* ws = a.ws;
    const bf16_t* RQ = (const bf16_t*)(ws + WS_RQ); const bf16_t* RK = (const bf16_t*)(ws + WS_RK);
    int head, row0, nsteps;
    if (mode == 0) { const int bh = ci / NG, g = ci % NG, b = bh >> 2; head = bh & 3; row0 = b * 8192 + g * (64 * CG); nsteps = CG; }
    else { const int bs = ci >> 2; head = ci & 3; row0 = MP + 64 * bs; nsteps = 1; }
    if (wave >= 4) {
        const int lt_ = tid - 256;
        {
            u32x4 r[16]; const size_t cgk = (size_t)(row0 >> 6);
            ret_stage_load(r, RQ, RK, (const bf16_t*)(ws + WS_RKT) + (cgk * 4 + head) * 8192, (const bf16_t*)(ws + WS_RVT) + (cgk * 4 + head) * 8192, row0, head, lt_);
            ret_stage_store(r, lds, lt_);
        }
        __syncthreads();
        for (int step = 0; step < nsteps; ++step) {
            const int rc = row0 + 64 * step;
            LAS unsigned char* nxt = lds + ((step + 1) & 1) * RB_BYTES;
            u32x4 r[16];
            const bool more = step + 1 < nsteps;
            if (more) {
                const size_t cgk = (size_t)((rc + 64) >> 6);
                ret_stage_load(r, RQ, RK, (const bf16_t*)(ws + WS_RKT) + (cgk * 4 + head) * 8192, (const bf16_t*)(ws + WS_RVT) + (cgk * 4 + head) * 8192, rc + 64, head, lt_);
            }
            __syncthreads();
            if (more) ret_stage_store(r, nxt, lt_);
            __syncthreads();
        }
        return;
    }
    const int slice = wave & 3, h = lane >> 5, ln = lane & 31;
    const bf16_t* RG = (const bf16_t*)(ws + WS_RG);
    bf16_t* MIX = (bf16_t*)(ws + WS_MIX);
    LAS float* stats = (LAS float*)(lds + RB_STATS);
    float* sout;
    f32x16 T[4];
    if (mode == 0) {
        const int bh = ci / NG, g = ci % NG;
        sout = (g == NG - 1) ? a.out + O_SP + (size_t)bh * 16384 : nullptr;
        const float c16 = ex2((float)(64 * CG) * lg_gamma(head));
#pragma unroll
        for (int ms = 0; ms < 4; ++ms)
#pragma unroll
            for (int i = 0; i < 16; ++i) T[ms][i] = 0.f;
        if (g > 0) {
            const float* lt0 = (const float*)(ws + WS_LT) + (size_t)((bh * (NG - 1)) * 4 + slice) * 4096 + lane;
            f32x16 L[4];
#pragma unroll
            for (int ms = 0; ms < 4; ++ms)
#pragma unroll
                for (int i = 0; i < 16; ++i) L[ms][i] = lt0[(ms * 16 + i) * 64];
            for (int gp = 0; gp < g; ++gp) {
                f32x16 N[4];
                const float* ltn = lt0 + (size_t)((gp + 1 < g ? gp + 1 : gp) * 4) * 4096;
#pragma unroll
                for (int ms = 0; ms < 4; ++ms)
#pragma unroll
                    for (int i = 0; i < 16; ++i) N[ms][i] = ltn[(ms * 16 + i) * 64];
#pragma unroll
                for (int ms = 0; ms < 4; ++ms) { T[ms] = T[ms] * c16 + L[ms]; L[ms] = N[ms]; }
            }
        }
    } else {
        sout = a.out + O_SS + (size_t)ci * 16384;
        const float* s0 = a.in[4] + (size_t)ci * 16384;
        const float ig = ex2(-63.f * lg_gamma(head));
#pragma unroll
        for (int ms = 0; ms < 4; ++ms)
#pragma unroll
            for (int i = 0; i < 16; ++i) T[ms][i] = s0[(32 * ms + 8 * (i >> 2) + 4 * h + (i & 3)) * 128 + 32 * slice + ln] * ig;
    }
    const float c = ex2(64.f * lg_gamma(head));
    __syncthreads();
    for (int step = 0; step < nsteps; ++step) {
        const int rc = row0 + 64 * step;
        const LAS unsigned char* cur = lds + (step & 1) * RB_BYTES;
        LAS float* st = stats + (step & 1) * 512;
        f32x16 out[2]; u32x2 gt[2][4];
#pragma unroll
        for (int is = 0; is < 2; ++is)
#pragma unroll
            for (int g4 = 0; g4 < 4; ++g4) gt[is][g4] = *(const u32x2*)(RG + (size_t)(rc + 32 * is + ln) * 512 + head * 128 + 32 * slice + 8 * g4 + 4 * h);
#pragma unroll
        for (int is = 0; is < 2; ++is)
#pragma unroll
            for (int i = 0; i < 16; ++i) out[is][i] = 0.f;
        const LAS unsigned char* qrow = cur + RB_Q + ln * RB_ROW; const LAS unsigned char* krow = cur + RB_K + ln * RB_ROW;
#pragma unroll
        for (int ms = 0; ms < 4; ++ms)
#pragma unroll
            for (int s = 0; s < 2; ++s) {
                const bf16x8 tb = pack8(T[ms], s);
#pragma unroll
                for (int is = 0; is < 2; ++is) out[is] = MFMA32(tb, lds44(qrow + is * 32 * RB_ROW + (32 * ms + 16 * s + 4 * h) * 2, 16), out[is]);
            }
#pragma unroll
        for (int is = 0; is < 2; ++is) out[is] = out[is] * c;
#pragma unroll
        for (int blk = 0; blk < 3; ++blk) {
            const int js = blk == 2 ? 1 : 0, is = blk == 0 ? 0 : 1;
            f32x16 P;
#pragma unroll
            for (int i = 0; i < 16; ++i) P[i] = 0.f;
#pragma unroll
            for (int ks = 0; ks < 8; ++ks) P = MFMA32(lds8(krow + js * 32 * RB_ROW + (16 * ks + 8 * h) * 2), lds8(qrow + is * 32 * RB_ROW + (16 * ks + 8 * h) * 2), P);
            if (js == is) {
#pragma unroll
                for (int i = 0; i < 16; ++i) P[i] = (8 * (i >> 2) + 4 * h + (i & 3)) <= ln ? P[i] : 0.f;
            }
#pragma unroll
            for (int s = 0; s < 2; ++s) out[is] = MFMA32(lds44(cur + RB_VT + ((4 * js + 2 * s) * 128 + 32 * slice + ln) * 16 + 8 * h, 2048), pack8(P, s), out[is]);
        }
        {
            bf16x8 vfr[4];
#pragma unroll
            for (int ks = 0; ks < 4; ++ks) vfr[ks] = lds8(cur + RB_VT + ((2 * ks + h) * 128 + 32 * slice + ln) * 16);
#pragma unroll
            for (int ms = 0; ms < 4; ++ms) {
                T[ms] = T[ms] * c;
#pragma unroll
                for (int ks = 0; ks < 4; ++ks) T[ms] = MFMA32(lds8(cur + RB_KT + ((2 * ks + h) * 128 + 32 * ms + ln) * 16), vfr[ks], T[ms]);
            }
        }
#pragma unroll
        for (int is = 0; is < 2; ++is) {
            float s1 = 0.f, s2 = 0.f;
#pragma unroll
            for (int i = 0; i < 16; ++i) { s1 += out[is][i]; s2 += out[is][i] * out[is][i]; }
            s1 += __shfl_xor(s1, 32); s2 += __shfl_xor(s2, 32);
            if (h == 0) { st[slice * 128 + 2 * (32 * is + ln)] = s1; st[slice * 128 + 2 * (32 * is + ln) + 1] = s2; }
        }
        __syncthreads();
#pragma unroll
        for (int is = 0; is < 2; ++is) {
            float t1 = 0.f, t2 = 0.f;
#pragma unroll
            for (int sl = 0; sl < 4; ++sl) { t1 += st[sl * 128 + 2 * (32 * is + ln)]; t2 += st[sl * 128 + 2 * (32 * is + ln) + 1]; }
            const float mean = t1 * (1.f / 128.f), var = __builtin_fmaxf(t2 * (1.f / 128.f) - mean * mean, 0.f), rstd = __builtin_amdgcn_rsqf(var + EPS);
            const size_t row = (size_t)(rc + 32 * is + ln);
#pragma unroll
            for (int g4 = 0; g4 < 4; ++g4) {
                const int d0 = 32 * slice + 8 * g4 + 4 * h;
                const u32x2 gg = gt[is][g4];
                const float g0 = __builtin_bit_cast(float, gg.x << 16), g1 = __builtin_bit_cast(float, gg.x & 0xffff0000u), g2 = __builtin_bit_cast(float, gg.y << 16), g3 = __builtin_bit_cast(float, gg.y & 0xffff0000u);
                u32x2 w; w.x = pk2((out[is][4 * g4] - mean) * rstd * g0, (out[is][4 * g4 + 1] - mean) * rstd * g1);
                w.y = pk2((out[is][4 * g4 + 2] - mean) * rstd * g2, (out[is][4 * g4 + 3] - mean) * rstd * g3);
                *(u32x2*)(MIX + row * D + 512 + head * 128 + d0) = w;
            }
        }
        __syncthreads();
    }
    if (sout) {
        const float gsc = ex2(63.f * lg_gamma(head));
#pragma unroll
        for (int ms = 0; ms < 4; ++ms)
#pragma unroll
            for (int i = 0; i < 16; ++i) sout[(32 * ms + 8 * (i >> 2) + 4 * h + (i & 3)) * 128 + 32 * slice + ln] = T[ms][i] * gsc;
    }
}

#define RLX_AGENT __ATOMIC_RELAXED, __HIP_MEMORY_SCOPE_AGENT
#define XB_TMO      128
#define XB_XCNT(j)  (256  + 64 * (j))
#define XB_XSUB(j)  (1280 + 64 * (j))
#define XB_XGEN(j)  (2304 + 64 * (j))
#define XB_TOP      3328
#define XB_TOPGEN   3392
#define XCD_BAR_WORDS 3456
#define XB_SPIN_CAP (1u << 18)

__device__ __forceinline__ unsigned xb_ld(unsigned* p)              { return __hip_atomic_load(p, __ATOMIC_RELAXED, __HIP_MEMORY_SCOPE_AGENT); }
__device__ __forceinline__ unsigned xb_add(unsigned* p, unsigned v) { return __hip_atomic_fetch_add(p, v, __ATOMIC_RELAXED, __HIP_MEMORY_SCOPE_AGENT); }
__device__ __forceinline__ unsigned xb_xcc_id() { return (unsigned)__builtin_amdgcn_s_getreg((3 << 11) | 20) & 0xFu; }
#define XB_SPIN(cond, bar) do { unsigned _sp = 0; while (cond) { __builtin_amdgcn_s_sleep(1); \
    if ((++_sp & 255u) == 0u) { if (xb_ld(&(bar)[XB_TMO])) break; if (_sp > XB_SPIN_CAP) { atomicAdd(&(bar)[XB_TMO], 1u); break; } } } } while (0)

struct XcdBarrier {
    unsigned* bar; unsigned x;
    volatile LAS unsigned* st;
};

__device__ __forceinline__ XcdBarrier xcd_barrier_post(unsigned* bar, volatile LAS unsigned* st) {
    XcdBarrier b; b.bar = bar; b.x = xb_xcc_id(); b.st = st;
    if (threadIdx.x == 0) (void)xb_add(&bar[XB_XCNT(b.x)], 1u);
    return b;
}
__device__ __forceinline__ void xcd_barrier_complete(unsigned* bar, unsigned x, unsigned& nloc, unsigned& nx) {
    const unsigned G = gridDim.x * gridDim.y * gridDim.z;
    unsigned sum, cnt, mine, sp = 0u;
    for (;;) {
        sum = 0u; cnt = 0u; mine = 0u;
#pragma unroll
        for (unsigned j = 0; j < 16; ++j) { const unsigned c = xb_ld(&bar[XB_XCNT(j)]); sum += c; cnt += (c > 0u) ? 1u : 0u; mine = (j == x) ? c : mine; }
        if (sum == G) break;
        __builtin_amdgcn_s_sleep(1);
        if ((++sp & 255u) == 0u) { if (xb_ld(&bar[XB_TMO])) break; if (sp > XB_SPIN_CAP) { atomicAdd(&bar[XB_TMO], 1u); break; } }
    }
    nloc = mine > 0u ? mine : 1u; nx = cnt > 0u ? cnt : 1u;
}

__device__ __forceinline__ void xcd_barrier(const XcdBarrier& b) {
    asm volatile("s_waitcnt vmcnt(0)" ::: "memory");
    __syncthreads();
    if (threadIdx.x == 0) {
        unsigned* bar = b.bar;
        __builtin_amdgcn_s_waitcnt(0);
        unsigned nloc = b.st[0], nx = b.st[1];
        if (nloc == 0u) { xcd_barrier_complete(bar, b.x, nloc, nx); b.st[0] = nloc; b.st[1] = nx; }
        const unsigned old = xb_add(&bar[XB_XSUB(b.x)], 1u);
        const unsigned gen = old / nloc;
        if (old + 1u == (gen + 1u) * nloc) {
            __builtin_amdgcn_fence(__ATOMIC_RELEASE, "agent");
            asm volatile("s_waitcnt vmcnt(0)" ::: "memory");
            const unsigned og = xb_add(&bar[XB_TOP], 1u);
            const unsigned tg = og / nx;
            if (og + 1u == (tg + 1u) * nx) xb_add(&bar[XB_TOPGEN], 1u);
            else XB_SPIN(xb_ld(&bar[XB_TOPGEN]) == tg, bar);
            __builtin_amdgcn_fence(__ATOMIC_ACQUIRE, "agent");
            xb_add(&bar[XB_XGEN(b.x)], 1u);
            asm volatile("s_waitcnt vmcnt(0)" ::: "memory");
        } else {
            XB_SPIN(xb_ld(&bar[XB_XGEN(b.x)]) == gen, bar);
            __builtin_amdgcn_fence(__ATOMIC_ACQUIRE, "agent");
            asm volatile("s_waitcnt vmcnt(0)" ::: "memory");
        }
    }
    __syncthreads();
}

__global__ void __launch_bounds__(512, 2) fwd(Args a) {
    extern __shared__ __attribute__((aligned(16))) unsigned char lds_raw[];
    LAS unsigned char* lds = (LAS unsigned char*)lds_raw;
    cg::grid_group grid = cg::this_grid();
    const int tid0 = threadIdx.x;
    unsigned char* ws = a.ws;
    volatile LAS unsigned* bst = (volatile LAS unsigned*)(lds + LDS_BYTES - 64);
    if (tid0 < 2) bst[tid0] = 0u;
    __syncthreads();
    XcdBarrier bar; bar.bar = (unsigned*)(ws + WS_BAR); bar.x = 0; bar.st = bst;
    float* mod = (float*)(ws + WS_MOD);
    bf16_t* XN = (bf16_t*)(ws + WS_XN);
    constexpr int NPI = 12 + (PH_DUP >= 0 ? 1 : 0);
    for (int pi = 0; pi < NPI; ++pi) {
        const int ph = (PH_DUP >= 0 && pi > PH_DUP) ? pi - 1 : pi;
        int tid = tid0; asm volatile("" : "+v"(tid));
        const int lane = tid & 63, wave = __builtin_amdgcn_readfirstlane(tid >> 6);
        if (ph == 0 && PHON(0)) {
            p0_prologue(a, lds, tid, wave, lane, pi == 0);
        } else if ((ph == 1 || ph == 4 || ph == 9) && PHON(1)) {
            const float* sP = ph == 1 ? a.in[0] : a.out; const float* sS = ph == 1 ? a.in[1] : a.out + (size_t)MP * D;
            const float* gain = ph == 1 ? a.in[9] : ph == 4 ? a.in[10] : a.in[11];
            const int k = ph == 1 ? 0 : ph == 4 ? 3 : 6;
            norm_phase(sP, sS, ph == 1 ? nullptr : (const bf16_t*)(ws + WS_XB), gain, mod, k * D, (k + 1) * D, XN, wave, lane);
        } else if ((ph == 2 || ph == 10) && PHON(2)) {
            pg8::Gemm g{XN, (const bf16_t*)(ws + (ph == 2 ? WS_WUP1 : WS_WUP2)), M, NUP, D, 0}; pg8::StaticOrder S; S.init(M, NUP, D, (int)gridDim.x, (int)blockIdx.x);
            EpiSwiGLU E{(bf16_t*)(ws + WS_ACT)};
            pg8::gemm_phase<EpiSwiGLU, pg8::StaticOrder, true, true>(lds, g, S, E);
        } else if ((ph == 3 || ph == 8 || ph == 11) && PHON(3)) {
            const bf16_t* A = (const bf16_t*)(ws + (ph == 8 ? WS_MIX : WS_ACT));
            const bf16_t* W = (const bf16_t*)(ws + (ph == 3 ? WS_WDN1 : ph == 8 ? WS_WOUT : WS_WDN2));
            pg8::Gemm g{A, W, M, D, ph == 8 ? D : FF, ph == 8 ? 0 : 1}; pg8::StaticOrder S; S.init(M, D, ph == 8 ? D : FF, (int)gridDim.x, (int)blockIdx.x);
            EpiResid E{a.in[0], a.in[1], a.out, mod, (ph == 3 ? 2 : ph == 8 ? 5 : 8) * D, ph == 8 ? 1.f : 0.5f, ph == 3 ? 0 : ph == 8 ? 1 : 2};
            pg8::gemm_phase<EpiResid, pg8::StaticOrder, true, true>(lds, g, S, E);
        } else if (ph == 5 && PHON(5)) {
            pg8::Gemm g{XN, (const bf16_t*)(ws + WS_WIN), M, NIN, D, 0}; pg8::StaticOrder S; S.init(M, NIN, D, (int)gridDim.x, (int)blockIdx.x);
            EpiIn E{a.in[15], a.in[16], (const f32x2*)(ws + WS_ROPE), a.out, ws};
            pg8::gemm_phase<EpiIn, pg8::StaticOrder, true, true>(lds, g, S, E);
        } else if (ph == 6 && PHON(6)) {
            unsigned* q = (unsigned*)(ws + WS_CTL) + 64 + 512 * (pi & 1);
            const int x0 = (int)(xb_xcc_id() & 7u);
            constexpr int QS = 64, QA = (16 * (NG - 1) * 4) / 8, QP = (MP / 32) * 8 / 8, QN = QS + QA + QP;
            for (int dx = 0; dx < 8; ++dx) {
                const int x = (x0 + dx) & 7;
                for (;;) {
                    unsigned k = 0;
                    if (lane == 0) k = __hip_atomic_fetch_add(q + 64 * x, 1u, __ATOMIC_RELAXED, __HIP_MEMORY_SCOPE_AGENT);
                    k = (unsigned)__builtin_amdgcn_readfirstlane((int)k);
                    if (k >= (unsigned)QN) break;
                    if (k >= (unsigned)QS && k < (unsigned)(QS + QA)) ret_passA(x * QA + (int)k - QS, ws, lane);
                    else sb_item(k < (unsigned)QS ? (MP / 32) * 8 + x * QS + (int)k : x * QP + (int)k - (QS + QA), a, lane);
                }
            }
        } else if (ph == 7 && PHON(7)) {
            const int G = (int)gridDim.x, nit = 16 * NG + 128;
            for (int k = 0;; ++k) {
                int bi;
                if (G == 16 * NG) { const int g = (int)blockIdx.x % NG; if (k == 0) bi = (int)blockIdx.x; else if (k == 1 && g < NG / 2) bi = 16 * NG + ((int)blockIdx.x / NG) * (NG / 2) + g; else break; }
                else { bi = (int)blockIdx.x + k * G; if (bi >= nit) break; }
                ret_block(bi >= 16 * NG, bi >= 16 * NG ? bi - 16 * NG : bi, a, lds, tid, wave, lane);
            }
        }
        if (pi == 0) { grid.sync(); bar = xcd_barrier_post((unsigned*)(ws + WS_BAR), bst); }
        else if (pi < NPI - 1) xcd_barrier(bar);
        if (PHREP(12)) xcd_barrier(bar);
    }
}
}

extern "C" void kernel_launch(void* const* d_in, const int* in_sizes, int n_in, void* d_out, int out_size, void* d_ws, size_t ws_size, hipStream_t stream) {
    static int grid = 0;
    if (grid == 0) {
        if (n_in != 20 || ws_size < mk::WS_END) { fprintf(stderr, "kernel_launch: unexpected inputs (n_in %d, ws %zu)\n", n_in, ws_size); grid = -1; return; }
        int dev = 0, cus = 0, per_cu = 0;
        hipGetDevice(&dev);
        hipDeviceGetAttribute(&cus, hipDeviceAttributeMultiprocessorCount, dev);
        hipFuncSetAttribute((const void*)mk::fwd, hipFuncAttributeMaxDynamicSharedMemorySize, mk::LDS_BYTES);
        hipOccupancyMaxActiveBlocksPerMultiprocessor(&per_cu, (const void*)mk::fwd, 512, mk::LDS_BYTES);
        if (per_cu < 1) per_cu = 1;
        grid = cus * per_cu;
        (void)hipGetLastError();
    }
    if (grid < 0) return;
    mk::Args a{};
    for (int i = 0; i < 20; ++i) a.in[i] = (const float*)d_in[i];
    a.out = (float*)d_out; a.ws = (unsigned char*)d_ws;
    void* args[] = {&a};
    hipError_t e = hipLaunchCooperativeKernel((const void*)mk::fwd, dim3(grid), dim3(512), args, mk::LDS_BYTES, stream);
    if (e != hipSuccess) fprintf(stderr, "cooperative launch failed: %s (grid %d)\n", hipGetErrorString(e), grid);
}
```

```cpp
#include <hip/hip_runtime.h>
#include <hip/hip_cooperative_groups.h>
#include <cstdio>
#include <cstdint>
namespace cg = cooperative_groups;
namespace pg8 {
#define PG8_LAS __attribute__((address_space(3)))
typedef unsigned short bf16_t;
typedef short bf16x8 __attribute__((ext_vector_type(8)));
typedef float f32x4 __attribute__((ext_vector_type(4)));
typedef unsigned u32x4 __attribute__((ext_vector_type(4)));
constexpr int BM = 256, BK = 64, HALF = 128, HTB = HALF * BK * 2  , STAGE_BYTES = 8 * HTB, NXCD = 8, WGM = 8;

__host__ __device__ __forceinline__ int lds_byte(int r, int c) { const int st = (r >> 4) * 2 + (c >> 5), rr = r & 15, cc = c & 31, ob = rr * 64 + cc * 2; return st * 1024 + (ob ^ (((ob >> 9) & 1) << 5)); }
__host__ __device__ __forceinline__ void stage_rc(int b, int& R, int& C) { const int st = b / 1024, sb = b % 1024, swz = sb ^ (((sb >> 9) & 1) << 5); R = (st >> 1) * 16 + swz / 64; C = (st & 1) * 32 + (swz % 64) / 2; }
__host__ __device__ __forceinline__ int perm32(int rho) { const int n = rho >> 4, i = rho & 15; return 8 * (i >> 2) + 4 * n + (i & 3); }

struct Unit { int pm, pn, kt0, nkt, aux; };
struct Gemm { const bf16_t* A; const bf16_t* Bt; int M, N, K; int a_blk; };

struct StaticOrder {
    int nM, nN, nwg, G, c, nt;
    __host__ __device__ void init(int M, int N, int K, int G_, int c_) { nM = M / BM; nN = N / BM; nwg = nM * nN; G = G_; c = c_; nt = K / BK; }
    __host__ __device__ bool next(int i, Unit& u) const {
        const long L = (long)i * G + c; if (L >= nwg) return false;
        int wgid = (int)L; { const int q = nwg / NXCD, r = nwg % NXCD, xcd = wgid % NXCD, off = wgid / NXCD; wgid = (xcd < r ? xcd * (q + 1) : r * (q + 1) + (xcd - r) * q) + off; }
        const int nig = WGM * nN, gid = wgid / nig, fm = gid * WGM, gsz = (nM - fm) < WGM ? (nM - fm) : WGM;
        u.pm = fm + ((wgid % nig) % gsz); u.pn = (wgid % nig) / gsz; u.kt0 = 0; u.nkt = nt; u.aux = 0; return true;
    }
    __device__ __forceinline__ void a_ready(const Unit&) const {}
    __device__ __forceinline__ void done(const Unit&) const {}
};
__device__ __forceinline__ unsigned cvt_pk_bf16(float lo, float hi) { unsigned r; asm volatile("v_cvt_pk_bf16_f32 %0, %1, %2" : "=v"(r) : "v"(lo), "v"(hi)); return r; }
template <class Epi, class Sched, bool ALIGN_EPI = false, bool SP2 = false>
__device__ __forceinline__ void gemm_phase(PG8_LAS unsigned char* lds, const Gemm g, const Sched& S, const Epi& E) {
    int tid_ = threadIdx.x; asm volatile("" : "+v"(tid_));
    const int tid = tid_, wid = __builtin_amdgcn_readfirstlane(tid >> 6), lane = tid & 63, wr = wid >> 2, wc = wid & 3, fr = lane & 15, fq = lane >> 4;
    const int K = g.K;
    unsigned voffA[2], voffB[2];
#pragma unroll
    for (int i = 0; i < 2; ++i) { int R, C; stage_rc(tid * 16 + i * 8192, R, C); const int Rb = Epi::PERM ? ((R & ~31) + perm32(R & 31)) : R;
        voffA[i] = (unsigned)(R * (g.a_blk ? BK : K) + C) * 2u; voffB[i] = (unsigned)(Rb * K + C) * 2u; }
    const size_t kstep = (size_t)(BK * 2);
    const size_t hstep = (size_t)HALF * K * 2;
    const size_t tstep = 2 * hstep;
    const size_t kstepA = g.a_blk ? (size_t)(BM * BK * 2) : kstep, hstepA = g.a_blk ? (size_t)(HALF * BK * 2) : hstep;
    const unsigned ldsw = (unsigned)wid * 1024u;
    const int aoff = lds_byte(wr * 64 + fr, fq * 8), boff = lds_byte(wc * 32 + fr, fq * 8);
#define PG8_SA(b, h) (((b) * 2 + (h)) * HTB)
#define PG8_SB(b, h) ((4 + (b) * 2 + (h)) * HTB)
#define PG8_STAGE(bufoff, gbase, voff) do { _Pragma("unroll") for (int _i = 0; _i < 2; ++_i) \
        __builtin_amdgcn_global_load_lds((const unsigned*)((const char*)(gbase) + (voff)[_i]), (PG8_LAS unsigned*)(lds + (bufoff) + ldsw + _i * 8192), 16, 0, 0); } while (0)
#define PG8_LDA(dst, b, h) do { _Pragma("unroll") for (int m = 0; m < 4; ++m) _Pragma("unroll") for (int k = 0; k < 2; ++k) dst[m][k] = *(const PG8_LAS bf16x8*)(lds + PG8_SA(b, h) + aoff + m * 2048 + k * 1024); } while (0)
#define PG8_LDB(dst, b, h) do { _Pragma("unroll") for (int n = 0; n < 2; ++n) _Pragma("unroll") for (int k = 0; k < 2; ++k) dst[n][k] = *(const PG8_LAS bf16x8*)(lds + PG8_SB(b, h) + boff + n * 2048 + k * 1024); } while (0)
#define PG8_MMA(ai, bj, At, Bt) do { __builtin_amdgcn_s_setprio(1); _Pragma("unroll") for (int m = 0; m < 4; ++m) _Pragma("unroll") for (int n = 0; n < 2; ++n) _Pragma("unroll") for (int k = 0; k < 2; ++k) \
        acc[ai][bj][m][n] = __builtin_amdgcn_mfma_f32_16x16x32_bf16(Bt[n][k], At[m][k], acc[ai][bj][m][n], 0, 0, 0); __builtin_amdgcn_s_setprio(0); } while (0)
#define PG8_WAIT_V(n) asm volatile("s_waitcnt vmcnt(" #n ")" ::: "memory")
#define PG8_WAIT_L(n) asm volatile("s_waitcnt lgkmcnt(" #n ")" ::: "memory")
#define PG8_BAR __builtin_amdgcn_s_barrier()
#define PG8_SCHED __builtin_amdgcn_sched_barrier(0)
    Unit cur, nxt; int ui = 0;
    if (!S.next(0, cur)) return;
    f32x4 acc[2][2][4][2];
#pragma unroll
    for (int a = 0; a < 2; ++a)
#pragma unroll
        for (int b = 0; b < 2; ++b)
#pragma unroll
            for (int m = 0; m < 4; ++m)
#pragma unroll
                for (int n = 0; n < 2; ++n) acc[a][b][m][n] = (f32x4){0.f, 0.f, 0.f, 0.f};
    bf16x8 At[4][2], B0[2][2], B1[2][2];
    const char* cA = (const char*)g.A + (size_t)cur.pm * tstep + (size_t)cur.kt0 * kstepA; const char* cB = (const char*)g.Bt + (size_t)cur.pn * tstep + (size_t)cur.kt0 * kstep;
    S.a_ready(cur);
    if constexpr (SP2) {
        PG8_STAGE(PG8_SB(0, 0), cB, voffB); PG8_STAGE(PG8_SB(0, 1), cB + hstep, voffB); PG8_STAGE(PG8_SA(0, 0), cA, voffA); PG8_STAGE(PG8_SA(0, 1), cA + hstepA, voffA);
        if (wr == 1) PG8_BAR;
        PG8_WAIT_V(2); PG8_BAR;
        PG8_STAGE(PG8_SB(1, 0), cB + kstep, voffB); PG8_STAGE(PG8_SA(1, 0), cA + kstepA, voffA); PG8_STAGE(PG8_SB(1, 1), cB + hstep + kstep, voffB);
        PG8_WAIT_V(6); PG8_BAR;
    } else {
        PG8_STAGE(PG8_SB(0, 0), cB, voffB); PG8_STAGE(PG8_SA(0, 0), cA, voffA); PG8_STAGE(PG8_SB(0, 1), cB + hstep, voffB); PG8_STAGE(PG8_SA(0, 1), cA + hstepA, voffA);
        if (wr == 1) PG8_BAR;
        PG8_WAIT_V(4); PG8_BAR;
        PG8_STAGE(PG8_SB(1, 0), cB + kstep, voffB); PG8_STAGE(PG8_SA(1, 0), cA + kstepA, voffA); PG8_STAGE(PG8_SB(1, 1), cB + hstep + kstep, voffB);
        PG8_WAIT_V(6); PG8_BAR;
    }
    for (;;) {
        const bool has_next = S.next(ui + 1, nxt);
        const char* nA = has_next ? (const char*)g.A + (size_t)nxt.pm * tstep + (size_t)nxt.kt0 * kstepA : cA; const char* nB = has_next ? (const char*)g.Bt + (size_t)nxt.pn * tstep + (size_t)nxt.kt0 * kstep : cB;
        const int nt = cur.nkt;
        for (int t = 0; t < nt; t += 2) {
            const bool last = (t == nt - 2);
            const char* a1 = cA + (size_t)(t + 1) * kstepA;
            const char* a2 = last ? nA : cA + (size_t)(t + 2) * kstepA; const char* b2 = last ? nB : cB + (size_t)(t + 2) * kstep;
            const char* a3 = a2 + kstepA; const char* b3 = b2 + kstep;
            if (last && has_next) S.a_ready(nxt);
            if constexpr (SP2) {
            PG8_LDB(B0, 0, 0); PG8_LDB(B1, 0, 1); PG8_SCHED; PG8_LDA(At, 0, 0); PG8_STAGE(PG8_SA(1, 1), a1 + hstepA, voffA);
            PG8_WAIT_V(8); PG8_WAIT_L(0); PG8_BAR; PG8_MMA(0, 0, At, B0); PG8_MMA(0, 1, At, B1); PG8_BAR; PG8_SCHED;
            PG8_LDA(At, 0, 1); PG8_STAGE(PG8_SB(0, 0), b2, voffB); PG8_STAGE(PG8_SB(0, 1), b2 + hstep, voffB); PG8_STAGE(PG8_SA(0, 0), a2, voffA);
            PG8_WAIT_V(8); PG8_WAIT_L(0); PG8_BAR; PG8_MMA(1, 0, At, B0); PG8_MMA(1, 1, At, B1); PG8_BAR; PG8_SCHED;
            PG8_LDB(B0, 1, 0); PG8_LDB(B1, 1, 1); PG8_SCHED; PG8_LDA(At, 1, 0); PG8_STAGE(PG8_SA(0, 1), a2 + hstepA, voffA);
            PG8_WAIT_V(8); PG8_WAIT_L(0); PG8_BAR; PG8_MMA(0, 0, At, B0); PG8_MMA(0, 1, At, B1); PG8_BAR; PG8_SCHED;
            PG8_LDA(At, 1, 1); PG8_STAGE(PG8_SB(1, 0), b3, voffB); PG8_STAGE(PG8_SB(1, 1), b3 + hstep, voffB); PG8_STAGE(PG8_SA(1, 0), a3, voffA);
            PG8_WAIT_V(8); PG8_WAIT_L(0); PG8_BAR; PG8_MMA(1, 0, At, B0); PG8_MMA(1, 1, At, B1); PG8_BAR; PG8_SCHED;
            } else {
            PG8_LDB(B0, 0, 0); PG8_SCHED; PG8_LDA(At, 0, 0); PG8_STAGE(PG8_SA(1, 1), a1 + hstepA, voffA);
            PG8_WAIT_L(8); PG8_BAR; PG8_WAIT_L(0); PG8_MMA(0, 0, At, B0); PG8_BAR; PG8_SCHED;
            PG8_LDB(B1, 0, 1); PG8_STAGE(PG8_SB(0, 0), b2, voffB);
            PG8_BAR; PG8_WAIT_L(0); PG8_MMA(0, 1, At, B1); PG8_BAR;
            PG8_LDA(At, 0, 1); PG8_STAGE(PG8_SA(0, 0), a2, voffA);
            PG8_BAR; PG8_WAIT_L(0); PG8_MMA(1, 0, At, B0); PG8_BAR; PG8_SCHED;
            PG8_STAGE(PG8_SB(0, 1), b2 + hstep, voffB);
            PG8_WAIT_V(6); PG8_BAR; PG8_MMA(1, 1, At, B1); PG8_BAR;
            PG8_LDB(B0, 1, 0); PG8_SCHED; PG8_LDA(At, 1, 0); PG8_STAGE(PG8_SA(0, 1), a2 + hstepA, voffA);
            PG8_WAIT_L(8); PG8_BAR; PG8_WAIT_L(0); PG8_MMA(0, 0, At, B0); PG8_BAR; PG8_SCHED;
            PG8_LDB(B1, 1, 1); PG8_STAGE(PG8_SB(1, 0), b3, voffB);
            PG8_BAR; PG8_WAIT_L(0); PG8_MMA(0, 1, At, B1); PG8_BAR;
            PG8_LDA(At, 1, 1); PG8_STAGE(PG8_SA(1, 0), a3, voffA);
            PG8_BAR; PG8_WAIT_L(0); PG8_MMA(1, 0, At, B0); PG8_BAR; PG8_SCHED;
            PG8_STAGE(PG8_SB(1, 1), b3 + hstep, voffB);
            PG8_WAIT_V(6); PG8_BAR; PG8_MMA(1, 1, At, B1); PG8_BAR;
            }
        }
        if constexpr (ALIGN_EPI) { if (wr == 0) PG8_BAR; }
        if constexpr (!Epi::AFTER_DRAIN) { E(acc, cur, wr, wc, fr, fq); S.done(cur); }
        if (!has_next) break;
#pragma unroll
        for (int a = 0; a < 2; ++a)
#pragma unroll
            for (int b = 0; b < 2; ++b)
#pragma unroll
                for (int m = 0; m < 4; ++m)
#pragma unroll
                    for (int n = 0; n < 2; ++n) acc[a][b][m][n] = (f32x4){0.f, 0.f, 0.f, 0.f};
        cur = nxt; cA = nA; cB = nB; ++ui;
        if constexpr (ALIGN_EPI) { if (wr == 1) PG8_BAR; }
    }
    PG8_WAIT_V(0);
    if constexpr (!ALIGN_EPI) { if (wr == 0) PG8_BAR; }
    PG8_BAR;
    if constexpr (Epi::AFTER_DRAIN) { E.fused(acc, cur, wr, wc, fr, fq, lds, wid, lane); S.done(cur); }
#undef PG8_SA
#undef PG8_SB
#undef PG8_STAGE
#undef PG8_LDA
#undef PG8_LDB
#undef PG8_MMA
#undef PG8_WAIT_V
#undef PG8_WAIT_L
#undef PG8_BAR
#undef PG8_SCHED
}
}

namespace mk {
using pg8::bf16_t; using pg8::bf16x8; using pg8::f32x4; using pg8::u32x4; using pg8::Unit;
#define DI __device__ __forceinline__
#define LAS __attribute__((address_space(3)))
typedef short s16x4 __attribute__((ext_vector_type(4)));
typedef float f32x16 __attribute__((ext_vector_type(16)));
typedef float f32x2 __attribute__((ext_vector_type(2)));
typedef unsigned u32x2 __attribute__((ext_vector_type(2)));
typedef __bf16 bf16x2_t __attribute__((ext_vector_type(2)));
#define MFMA32(a, b, c) __builtin_amdgcn_mfma_f32_32x32x16_bf16((a), (b), (c), 0, 0, 0)

constexpr int MP = 32768, MS = 2048, M = MP + MS, D = 1024, FF = 2816, NUP = 2 * FF, NIN = 3584, NMOD = 9 * D;
constexpr float EPS = 1e-6f, LOG2E = 1.4426950408889634f;
constexpr float QSCALE = 0.18033688011112042f;
constexpr float KSCALE = 0.08838834764831845f;
constexpr float SB_EXIT = 1e-30f;

constexpr size_t MiB = 1u << 20;
constexpr size_t WS_CTL = 0, WS_BAR = 65536, WS_MOD = 1 * MiB, WS_ROPE = 4 * MiB;
constexpr size_t WS_WUP1 = 8 * MiB, WS_WDN1 = 19 * MiB, WS_WIN = 25 * MiB, WS_WOUT = 32 * MiB, WS_WUP2 = 34 * MiB, WS_WDN2 = 45 * MiB;
constexpr size_t WS_XN = 60 * MiB, WS_BIG = 128 * MiB;
constexpr size_t WS_ACT = WS_BIG;
constexpr size_t WS_SBQ = WS_BIG, WS_SBK = WS_BIG + 34 * MiB, WS_SBVT = WS_BIG + 68 * MiB, WS_RQ = WS_BIG + 102 * MiB, WS_RK = WS_BIG + 136 * MiB,
                 WS_RKT = WS_BIG + 170 * MiB, WS_RVT = WS_BIG + 204 * MiB, WS_RG = WS_BIG + 238 * MiB, WS_MIX = WS_XN  , WS_LT = WS_BIG + 272 * MiB, WS_XB = WS_BIG + 288 * MiB, WS_END = WS_BIG + 356 * MiB;
constexpr int NG = 16, CG = 8;
constexpr size_t O_Y = 0, O_KP = 35651584, O_VP = 52428800, O_SP = 69206016, O_KS = 69468160, O_VS = 70516736, O_SS = 71565312;

constexpr int LDS_BYTES = 147456;
#ifndef PH_MASK
#define PH_MASK 0xFFF
#endif
#define PHON(k) ((PH_MASK >> (k)) & 1)
#ifndef PH_REP
#define PH_REP 0
#endif
#ifndef PH_DUP
#define PH_DUP -1
#endif
#define PHREP(k) ((PH_REP >> (k)) & 1)

DI unsigned pk2(float lo, float hi) { f32x2 v = {lo, hi}; bf16x2_t b = __builtin_convertvector(v, bf16x2_t); return __builtin_bit_cast(unsigned, b); }
DI float bf2f(unsigned short s) { return __builtin_bit_cast(float, (unsigned)s << 16); }
DI f32x4 bf4(u32x2 w) { f32x4 r; r[0] = __builtin_bit_cast(float, w.x << 16); r[1] = __builtin_bit_cast(float, w.x & 0xffff0000u); r[2] = __builtin_bit_cast(float, w.y << 16); r[3] = __builtin_bit_cast(float, w.y & 0xffff0000u); return r; }
DI int row_batch(int r) { return r < MP ? (r >> 13) : 4 + ((r - MP) >> 6); }
DI int row_pos(int r) { return r < MP ? (r & 8191) : 2048 + ((r - MP) & 63); }
DI float lg_gamma(int head) { return head == 0 ? -0.04580368961312479f : head == 1 ? -0.02272007650008353f : head == 2 ? -0.011315313227834146f : -0.005646563141142063f; }
DI float ex2(float x) { return __builtin_amdgcn_exp2f(x); }
DI float siluf(float g) { return g * __builtin_amdgcn_rcpf(1.f + ex2(-g * LOG2E)); }
DI float wave_sum(float v) {
#pragma unroll
    for (int o = 1; o < 64; o <<= 1) v += __shfl_xor(v, o);
    return v;
}
DI bf16x8 pack8(const f32x16& x, int s) {
    u32x4 p; p.x = pk2(x[8 * s], x[8 * s + 1]); p.y = pk2(x[8 * s + 2], x[8 * s + 3]); p.z = pk2(x[8 * s + 4], x[8 * s + 5]); p.w = pk2(x[8 * s + 6], x[8 * s + 7]);
    return __builtin_bit_cast(bf16x8, p);
}
DI bf16x8 ld8(const bf16_t* p) { return *(const bf16x8*)p; }
DI bf16x8 ld44(const bf16_t* p, int stride = 8) {
    const s16x4 lo = *(const s16x4*)p, hi = *(const s16x4*)(p + stride);
    return __builtin_shufflevector(lo, hi, 0, 1, 2, 3, 4, 5, 6, 7);
}

DI u32x4 tr8x8(u32x4 w, int lane) {
    { const bool b = (lane & 4) != 0;
      const unsigned s0 = b ? w.x : w.z, s1 = b ? w.y : w.w, r0 = __shfl_xor(s0, 4), r1 = __shfl_xor(s1, 4);
      if (b) { w.x = r0; w.y = r1; } else { w.z = r0; w.w = r1; } }
    { const bool b = (lane & 2) != 0;
      const unsigned s0 = b ? w.x : w.y, s1 = b ? w.z : w.w, r0 = __shfl_xor(s0, 2), r1 = __shfl_xor(s1, 2);
      if (b) { w.x = r0; w.z = r1; } else { w.y = r0; w.w = r1; } }
    { const bool b = (lane & 1) != 0;
      const unsigned p0 = __shfl_xor(w.x, 1), p1 = __shfl_xor(w.y, 1), p2 = __shfl_xor(w.z, 1), p3 = __shfl_xor(w.w, 1);
      if (b) { w.x = (p0 >> 16) | (w.x & 0xffff0000u); w.y = (p1 >> 16) | (w.y & 0xffff0000u); w.z = (p2 >> 16) | (w.z & 0xffff0000u); w.w = (p3 >> 16) | (w.w & 0xffff0000u); }
      else   { w.x = (w.x & 0xffffu) | (p0 << 16); w.y = (w.y & 0xffffu) | (p1 << 16); w.z = (w.z & 0xffffu) | (p2 << 16); w.w = (w.w & 0xffffu) | (p3 << 16); } }
    return w;
}

struct EpiSwiGLU {
    static constexpr bool PERM = true, AFTER_DRAIN = false;
    bf16_t* O;
    DI void operator()(const f32x4 (&acc)[2][2][4][2], const Unit& u, int wr, int wc, int fr, int fq) const {
        asm volatile("" : "+v"(fr), "+v"(fq));
        const int rl0 = wr * 64 + fr, kt = 2 * u.pn + (wc >> 1), cin = 32 * (wc & 1) + 8 * fq;
        bf16_t* blk = O + ((size_t)(u.pm * (FF / 64) + kt) * 256) * 64 + cin;
#pragma unroll
        for (int ai = 0; ai < 2; ++ai)
#pragma unroll
            for (int m = 0; m < 4; ++m) {
                const f32x4 g0 = acc[ai][0][m][0], g1 = acc[ai][0][m][1], u0 = acc[ai][1][m][0], u1 = acc[ai][1][m][1];
                u32x4 w;
                w.x = pk2(siluf(g0[0]) * u0[0], siluf(g0[1]) * u0[1]); w.y = pk2(siluf(g0[2]) * u0[2], siluf(g0[3]) * u0[3]);
                w.z = pk2(siluf(g1[0]) * u1[0], siluf(g1[1]) * u1[1]); w.w = pk2(siluf(g1[2]) * u1[2], siluf(g1[3]) * u1[3]);
                *(u32x4*)(blk + (size_t)(rl0 + ai * 128 + m * 16) * 64) = w;
            }
    }
};
struct EpiResid {
    static constexpr bool PERM = false, AFTER_DRAIN = false;
    const float* baseP; const float* baseS; float* out; const float* mod; int gofs; float gscale; int mode;
    DI void operator()(const f32x4 (&acc)[2][2][4][2], const Unit& u, int wr, int wc, int fr, int fq) const {
        asm volatile("" : "+v"(fr), "+v"(fq));
        const int row0 = u.pm * 256 + wr * 64 + fr, col0 = u.pn * 256 + wc * 32 + 4 * fq;
        bf16_t* xb = (bf16_t*)((unsigned char*)const_cast<float*>(mod) + (WS_XB - WS_MOD));
#pragma unroll
        for (int ai = 0; ai < 2; ++ai) {
            const float* mb = mod + (size_t)row_batch(u.pm * 256 + ai * 128 + wr * 64) * NMOD + gofs;
            f32x4 gv[2][2];
#pragma unroll
            for (int bj = 0; bj < 2; ++bj)
#pragma unroll
                for (int n = 0; n < 2; ++n) gv[bj][n] = *(const f32x4*)(mb + col0 + bj * 128 + n * 16) * gscale;
#pragma unroll
            for (int m = 0; m < 4; ++m) {
                const int row = row0 + ai * 128 + m * 16;
                f32x4 bv[2][2];
                if (mode == 0) {
                    const float* bp = row < MP ? baseP + (size_t)row * D : baseS + (size_t)(row - MP) * D;
#pragma unroll
                    for (int bj = 0; bj < 2; ++bj)
#pragma unroll
                        for (int n = 0; n < 2; ++n) bv[bj][n] = *(const f32x4*)(bp + col0 + bj * 128 + n * 16);
                } else {
#pragma unroll
                    for (int bj = 0; bj < 2; ++bj)
#pragma unroll
                        for (int n = 0; n < 2; ++n) bv[bj][n] = bf4(*(const u32x2*)(xb + (size_t)row * D + col0 + bj * 128 + n * 16));
                }
#pragma unroll
                for (int bj = 0; bj < 2; ++bj)
#pragma unroll
                    for (int n = 0; n < 2; ++n) {
                        const f32x4 o = bv[bj][n] + gv[bj][n] * acc[ai][bj][m][n];
                        if (mode == 2) *(f32x4*)(out + (size_t)row * D + col0 + bj * 128 + n * 16) = o;
                        else { u32x2 w; w.x = pk2(o[0], o[1]); w.y = pk2(o[2], o[3]); *(u32x2*)(xb + (size_t)row * D + col0 + bj * 128 + n * 16) = w; }
                    }
            }
        }
    }
};
struct EpiIn {
    static constexpr bool PERM = true, AFTER_DRAIN = false;
    const float* gq; const float* gk; const f32x2* tab;
    float* outf;
    unsigned char* ws;
    DI void operator()(const f32x4 (&acc)[2][2][4][2], const Unit& u, int wr, int wc, int fr, int fq) const {
        asm volatile("" : "+v"(fr), "+v"(fq));
        const int pn = u.pn, rbase = u.pm * 256 + wr * 64 + fr, e0 = 8 * fq;
        if (pn < 4) {
            const bool isk = pn >= 2; const int head = 4 * (pn & 1) + wc;
            const float* gain = isk ? gk : gq;
            f32x4 gv[2][2];
#pragma unroll
            for (int bj = 0; bj < 2; ++bj)
#pragma unroll
                for (int n = 0; n < 2; ++n) gv[bj][n] = *(const f32x4*)(gain + 32 * bj + e0 + 4 * n);
            bf16_t* ob = (bf16_t*)(ws + (isk ? WS_SBK : WS_SBQ));
#pragma unroll
            for (int ai = 0; ai < 2; ++ai)
#pragma unroll
                for (int m = 0; m < 4; ++m) {
                    const int row = rbase + ai * 128 + m * 16;
                    float ss = 0.f;
#pragma unroll
                    for (int bj = 0; bj < 2; ++bj)
#pragma unroll
                        for (int n = 0; n < 2; ++n) { const f32x4 x = acc[ai][bj][m][n]; ss += (x[0] * x[0] + x[1] * x[1]) + (x[2] * x[2] + x[3] * x[3]); }
                    ss += __shfl_xor(ss, 16); ss += __shfl_xor(ss, 32);
                    float inv = __builtin_amdgcn_rsqf(ss * (1.f / 64.f) + EPS);
                    const float invq = isk ? inv : inv * QSCALE;
#pragma unroll
                    for (int bj = 0; bj < 2; ++bj) {
                        const f32x4 v0 = acc[ai][bj][m][0] * gv[bj][0], v1 = acc[ai][bj][m][1] * gv[bj][1];
                        const f32x4 w0 = v0 * invq, w1 = v1 * invq;
                        u32x4 w; w.x = pk2(w0[0], w0[1]); w.y = pk2(w0[2], w0[3]); w.z = pk2(w1[0], w1[1]); w.w = pk2(w1[2], w1[3]);
                        *(u32x4*)(ob + (size_t)row * 512 + head * 64 + 32 * bj + e0) = w;
                        if (isk) {
                            float* o = (row < MP ? outf + O_KP + (size_t)row * 512 : outf + O_KS + (size_t)(row - MP) * 512) + head * 64 + 32 * bj + e0;
                            *(f32x4*)o = w0; *(f32x4*)(o + 4) = w1;
                        }
                    }
                }
        } else if (pn < 6) {
            const int head = 4 * (pn - 4) + wc;
            bf16_t* vt = (bf16_t*)(ws + WS_SBVT);
#pragma unroll
            for (int ai = 0; ai < 2; ++ai)
#pragma unroll
                for (int m = 0; m < 4; ++m) {
                    const int row = rbase + ai * 128 + m * 16;
                    float* o = (row < MP ? outf + O_VP + (size_t)row * 512 : outf + O_VS + (size_t)(row - MP) * 512) + head * 64 + e0;
                    bf16_t* t = vt + (((size_t)((row >> 5) * 8 + head) * 4 + ((row >> 3) & 3)) * 64 + e0 + (fr & 7)) * 8;
#pragma unroll
                    for (int bj = 0; bj < 2; ++bj) {
                        const f32x4 x0 = acc[ai][bj][m][0], x1 = acc[ai][bj][m][1];
                        *(f32x4*)(o + 32 * bj) = x0; *(f32x4*)(o + 32 * bj + 4) = x1;
                        u32x4 w; w.x = pk2(x0[0], x0[1]); w.y = pk2(x0[2], x0[3]); w.z = pk2(x1[0], x1[1]); w.w = pk2(x1[2], x1[3]);
                        *(u32x4*)(t + 32 * bj * 8) = tr8x8(w, fr);
                    }
                }
        } else {
            const int q = pn - 6, kind = q >> 1, head = 2 * (q & 1) + (wc >> 1), f0 = 32 * (wc & 1) + e0;
            const float lg = lg_gamma(head);
            if (kind <= 1) {
                bf16_t* ob = (bf16_t*)(ws + (kind ? WS_RK : WS_RQ));
                bf16_t* kt = (bf16_t*)(ws + WS_RKT);
#pragma unroll
                for (int ai = 0; ai < 2; ++ai)
#pragma unroll
                    for (int m = 0; m < 4; ++m) {
                        asm volatile("" ::: "memory");
                        const int row = rbase + ai * 128 + m * 16, pos = row_pos(row), ic = pos & 63;
                        const float sc = kind ? KSCALE * ex2(-(float)ic * lg) : ex2((float)ic * lg);
                        const f32x4* tp = (const f32x4*)(tab + (size_t)pos * 64 + f0);
                        f32x4 o1[2], o2[2];
#pragma unroll
                        for (int n = 0; n < 2; ++n) {
                            const f32x4 t0 = tp[2 * n], t1 = tp[2 * n + 1];
                            const f32x4 x1 = acc[ai][0][m][n], x2 = acc[ai][1][m][n];
                            const f32x4 cc = {t0[0], t0[2], t1[0], t1[2]}, sn = {t0[1], t0[3], t1[1], t1[3]};
                            o1[n] = (x1 * cc - x2 * sn) * sc; o2[n] = (x1 * sn + x2 * cc) * sc;
                        }
                        u32x4 w1, w2;
                        w1.x = pk2(o1[0][0], o1[0][1]); w1.y = pk2(o1[0][2], o1[0][3]); w1.z = pk2(o1[1][0], o1[1][1]); w1.w = pk2(o1[1][2], o1[1][3]);
                        w2.x = pk2(o2[0][0], o2[0][1]); w2.y = pk2(o2[0][2], o2[0][3]); w2.z = pk2(o2[1][0], o2[1][1]); w2.w = pk2(o2[1][2], o2[1][3]);
                        bf16_t* p = ob + (size_t)row * 512 + head * 128 + f0;
                        *(u32x4*)p = w1; *(u32x4*)(p + 64) = w2;
                        asm volatile("" ::: "memory");
                        if (kind) {
                            bf16_t* t = kt + (((size_t)((row >> 6) * 4 + head) * 8 + ((row >> 3) & 7)) * 128 + f0 + (fr & 7)) * 8;
                            *(u32x4*)t = tr8x8(w1, fr); *(u32x4*)(t + 64 * 8) = tr8x8(w2, fr);
                        }
                    }
            } else if (kind == 2) {
                bf16_t* vt = (bf16_t*)(ws + WS_RVT);
#pragma unroll
                for (int ai = 0; ai < 2; ++ai)
#pragma unroll
                    for (int m = 0; m < 4; ++m) {
                        const int row = rbase + ai * 128 + m * 16;
                        bf16_t* t = vt + (((size_t)((row >> 6) * 4 + head) * 8 + ((row >> 3) & 7)) * 128 + f0 + (fr & 7)) * 8;
#pragma unroll
                        for (int bj = 0; bj < 2; ++bj) {
                            const f32x4 x0 = acc[ai][bj][m][0], x1 = acc[ai][bj][m][1];
                            u32x4 w; w.x = pk2(x0[0], x0[1]); w.y = pk2(x0[2], x0[3]); w.z = pk2(x1[0], x1[1]); w.w = pk2(x1[2], x1[3]);
                            *(u32x4*)(t + 64 * bj * 8) = tr8x8(w, fr);
                        }
                    }
            } else {
                bf16_t* ob = (bf16_t*)(ws + WS_RG);
#pragma unroll
                for (int ai = 0; ai < 2; ++ai)
#pragma unroll
                    for (int m = 0; m < 4; ++m) {
                        const int row = rbase + ai * 128 + m * 16;
#pragma unroll
                        for (int bj = 0; bj < 2; ++bj) {
                            const f32x4 x0 = acc[ai][bj][m][0], x1 = acc[ai][bj][m][1];
                            u32x4 w; w.x = pk2(siluf(x0[0]), siluf(x0[1])); w.y = pk2(siluf(x0[2]), siluf(x0[3])); w.z = pk2(siluf(x1[0]), siluf(x1[1])); w.w = pk2(siluf(x1[2]), siluf(x1[3]));
                            *(u32x4*)(ob + (size_t)row * 512 + head * 128 + 64 * bj + f0) = w;
                        }
                    }
            }
        }
    }
};

DI int srccol_in(int cp) {
    const int pn = cp >> 8, loc = cp & 255, bj = loc >> 7, wc = (loc & 127) >> 5;
    if (pn < 6) { const int seg = pn >> 1, pp = pn & 1; return seg * 512 + 64 * (4 * pp + wc) + 32 * bj; }
    const int q = pn - 6, seg = q >> 1, pp = q & 1; return 1536 + seg * 512 + 128 * (2 * pp + (wc >> 1)) + 64 * bj + 32 * (wc & 1);
}
DI int srccol_up(int cp) { const int pn = cp >> 8, bj = (cp >> 7) & 1, i = cp & 127; return bj * FF + 128 * pn + i; }

DI void p0_transpose_item(const float* W, int K, int N, int srcc, bf16_t* WT, int dstr, int k0, LAS float* scr, int lane) {
#pragma unroll 8
    for (int i = 0; i < 32; ++i) { const int kk = 2 * i + (lane >> 5); scr[kk * 33 + (lane & 31)] = W[(size_t)(k0 + kk) * N + srcc + (lane & 31)]; }
    asm volatile("s_waitcnt lgkmcnt(0)" ::: "memory");
    const int c = lane & 7;
#pragma unroll
    for (int j = 0; j < 4; ++j) { const int n = (lane >> 3) + 8 * j; const LAS float* s = scr + (8 * c) * 33 + n;
        u32x4 o; o.x = pk2(s[0 * 33], s[1 * 33]); o.y = pk2(s[2 * 33], s[3 * 33]); o.z = pk2(s[4 * 33], s[5 * 33]); o.w = pk2(s[6 * 33], s[7 * 33]);
        *(u32x4*)(WT + (size_t)(dstr + n) * K + k0 + 8 * c) = o; }
    asm volatile("s_waitcnt lgkmcnt(0)" ::: "memory");
}
DI void ada_item(int it, const float* cP, const float* cS, const float* wada, const float* bada, float* mod, LAS float* red, int tid, int wave, int lane) {
    const int c0 = it * 64;
    LAS float* cs = red + wave * (64 * 36);
    float acc[36];
#pragma unroll
    for (int b = 0; b < 36; ++b) acc[b] = 0.f;
#pragma unroll 1
    for (int u = 0; u < 2; ++u) {
        const int kb = 128 * wave + 64 * u;
#pragma unroll 4
        for (int b = 0; b < 36; ++b) { const float cv = b < 4 ? cP[b * 1024 + kb + lane] : cS[(b - 4) * 1024 + kb + lane]; cs[lane * 36 + b] = cv / (1.f + __expf(-cv)); }
        asm volatile("s_waitcnt lgkmcnt(0)" ::: "memory");
#pragma unroll 1
        for (int k8 = 0; k8 < 8; ++k8) {
            float wv[8];
#pragma unroll
            for (int j = 0; j < 8; ++j) wv[j] = wada[(size_t)(kb + 8 * k8 + j) * NMOD + c0 + lane];
#pragma unroll
            for (int j = 0; j < 8; ++j) {
                const LAS f32x4* cr = (const LAS f32x4*)(cs + (8 * k8 + j) * 36);
#pragma unroll
                for (int q = 0; q < 9; ++q) { const f32x4 c4 = cr[q]; acc[4 * q] += c4[0] * wv[j]; acc[4 * q + 1] += c4[1] * wv[j]; acc[4 * q + 2] += c4[2] * wv[j]; acc[4 * q + 3] += c4[3] * wv[j]; }
            }
        }
        asm volatile("s_waitcnt lgkmcnt(0)" ::: "memory");
    }
    __syncthreads();
#pragma unroll
    for (int b = 0; b < 36; ++b) red[(wave * 36 + b) * 64 + lane] = acc[b];
    __syncthreads();
    for (int o = tid; o < 36 * 64; o += 512) {
        const int b = o >> 6, l = o & 63; float s = 0.f;
#pragma unroll
        for (int w = 0; w < 8; ++w) s += red[(w * 36 + b) * 64 + l];
        mod[(size_t)b * NMOD + c0 + l] = s + bada[c0 + l];
    }
    __syncthreads();
}

struct Args {
    const float* in[20]; float* out; unsigned char* ws;
};

DI void p0_prologue(const Args& a, LAS unsigned char* lds, int tid, int wave, int lane, bool first) {
    unsigned char* ws = a.ws;
    if (blockIdx.x == 0 && first) { for (int i = tid; i < 8192; i += 512) ((unsigned*)(ws + WS_CTL))[i] = 0u; for (int i = tid; i < 4096; i += 512) ((unsigned*)(ws + WS_BAR))[i] = 0u; }
    for (int it = blockIdx.x; it < NMOD / 64; it += gridDim.x)
        ada_item(it, a.in[5], a.in[6], a.in[7], a.in[8], (float*)(ws + WS_MOD), (LAS float*)lds, tid, wave, lane);
    for (int idx = blockIdx.x * 512 + tid; idx < 8192 * 64; idx += gridDim.x * 512) {
        const int pos = idx >> 6, f = idx & 63;
        const double xd = -(double)f * 0.20762050593046014; const double nf = __builtin_floor(xd);
        const float fr = (float)(xd - nf);
        const float ifr = __builtin_ldexpf(ex2(fr), (int)nf);
        const double rev = (double)pos * (double)ifr * 0.15915494309189535; const float frac = (float)(rev - __builtin_floor(rev));
        f32x2 cs; cs.x = __builtin_amdgcn_cosf(frac); cs.y = __builtin_amdgcn_sinf(frac);
        ((f32x2*)(ws + WS_ROPE))[idx] = cs;
    }
    LAS float* scr = (LAS float*)(lds + wave * 16384);
    const int gw = blockIdx.x * 8 + wave, NGW = gridDim.x * 8;
    constexpr int I_UP = (D / 64) * (NUP / 32), I_DN = (FF / 64) * (D / 32), I_IN = (D / 64) * (NIN / 32), I_OUT = (D / 64) * (D / 32);
    constexpr int NITEMS = 2 * I_UP + 2 * I_DN + I_IN + I_OUT;
    for (int it = gw; it < NITEMS; it += NGW) {
        int r = it;
        if (r < 2 * I_UP) { const int which = r >= I_UP; r -= which * I_UP; const int nb = r % (NUP / 32), kb = r / (NUP / 32);
            p0_transpose_item(a.in[which ? 18 : 12], D, NUP, srccol_up(32 * nb), (bf16_t*)(ws + (which ? WS_WUP2 : WS_WUP1)), 32 * nb, 64 * kb, scr, lane); continue; }
        r -= 2 * I_UP;
        if (r < 2 * I_DN) { const int which = r >= I_DN; r -= which * I_DN; const int nb = r % (D / 32), kb = r / (D / 32);
            p0_transpose_item(a.in[which ? 19 : 13], FF, D, 32 * nb, (bf16_t*)(ws + (which ? WS_WDN2 : WS_WDN1)), 32 * nb, 64 * kb, scr, lane); continue; }
        r -= 2 * I_DN;
        if (r < I_IN) { const int nb = r % (NIN / 32), kb = r / (NIN / 32);
            p0_transpose_item(a.in[14], D, NIN, srccol_in(32 * nb), (bf16_t*)(ws + WS_WIN), 32 * nb, 64 * kb, scr, lane); continue; }
        r -= I_IN;
        { const int nb = r % (D / 32), kb = r / (D / 32);
            p0_transpose_item(a.in[17], D, D, 32 * nb, (bf16_t*)(ws + WS_WOUT), 32 * nb, 64 * kb, scr, lane); }
    }
}

DI void norm_finish(int m, const f32x4 (&v)[4], float s, const float* gain, const float* mod, int shofs, int scofs, bf16_t* XN, int lane) {
    const float* mb = mod + (size_t)row_batch(m) * NMOD;
    const float inv = __builtin_amdgcn_rsqf(s * (1.f / D) + EPS);
    u32x2* o8 = (u32x2*)(XN + (size_t)m * D) + lane;
#pragma unroll
    for (int j = 0; j < 4; ++j) {
        const int c = 4 * (64 * j + lane);
        const f32x4 g4 = *(const f32x4*)(gain + c), sc4 = *(const f32x4*)(mb + scofs + c), sh4 = *(const f32x4*)(mb + shofs + c);
        const f32x4 o = v[j] * inv * g4 * (sc4 + 1.f) + sh4;
        u32x2 w; w.x = pk2(o[0], o[1]); w.y = pk2(o[2], o[3]); o8[64 * j] = w;
    }
}
DI void norm_phase(const float* srcP, const float* srcS, const bf16_t* srcB, const float* gain, const float* mod, int shofs, int scofs, bf16_t* XN, int wave, int lane) {
    const int gw = blockIdx.x * 8 + wave, NGW = gridDim.x * 8;
    for (int m = gw; m < M; m += 2 * NGW) {
        const int m2 = m + NGW; const bool two = m2 < M; const int mb2 = two ? m2 : m;
        const f32x4* xa = (const f32x4*)(m < MP ? srcP + (size_t)m * D : srcS + (size_t)(m - MP) * D) + lane;
        const f32x4* xb = (const f32x4*)(mb2 < MP ? srcP + (size_t)mb2 * D : srcS + (size_t)(mb2 - MP) * D) + lane;
        f32x4 va[4], vb[4]; float sa = 0.f, sb = 0.f;
        if (srcB) {
            const u32x2* ba = (const u32x2*)(srcB + (size_t)m * D) + lane; const u32x2* bb = (const u32x2*)(srcB + (size_t)mb2 * D) + lane;
#pragma unroll
            for (int j = 0; j < 4; ++j) { va[j] = bf4(ba[64 * j]); vb[j] = bf4(bb[64 * j]); }
        } else {
#pragma unroll
            for (int j = 0; j < 4; ++j) { va[j] = xa[64 * j]; vb[j] = xb[64 * j]; }
        }
#pragma unroll
        for (int j = 0; j < 4; ++j) { sa += (va[j][0] * va[j][0] + va[j][1] * va[j][1]) + (va[j][2] * va[j][2] + va[j][3] * va[j][3]); sb += (vb[j][0] * vb[j][0] + vb[j][1] * vb[j][1]) + (vb[j][2] * vb[j][2] + vb[j][3] * vb[j][3]); }
#pragma unroll
        for (int o = 1; o < 64; o <<= 1) { sa += __shfl_xor(sa, o); sb += __shfl_xor(sb, o); }
        norm_finish(m, va, sa, gain, mod, shofs, scofs, XN, lane);
        if (two) norm_finish(m2, vb, sb, gain, mod, shofs, scofs, XN, lane);
    }
}

DI void norm_row16_finish(int m, const f32x4 (&v)[4], float s, const float* gain, const float* mod, int shofs, int scofs, bf16_t* XN, int lane) {
    const float* mb = mod + (size_t)row_batch(m) * NMOD;
    const float inv = __builtin_amdgcn_rsqf(s * (1.f / D) + EPS);
#pragma unroll
    for (int j = 0; j < 2; ++j) {
        const int c = 8 * (64 * j + lane);
        u32x4 w;
#pragma unroll
        for (int q = 0; q < 2; ++q) {
            const f32x4 g4 = *(const f32x4*)(gain + c + 4 * q), sc4 = *(const f32x4*)(mb + scofs + c + 4 * q), sh4 = *(const f32x4*)(mb + shofs + c + 4 * q);
            const f32x4 o = v[2 * j + q] * inv * g4 * (sc4 + 1.f) + sh4;
            if (q == 0) { w.x = pk2(o[0], o[1]); w.y = pk2(o[2], o[3]); } else { w.z = pk2(o[0], o[1]); w.w = pk2(o[2], o[3]); }
        }
        *(u32x4*)(XN + (size_t)m * D + c) = w;
    }
}
DI void norm_phase_b16(const bf16_t* src, const float* gain, const float* mod, int shofs, int scofs, bf16_t* XN, int wave, int lane) {
    const int gw = blockIdx.x * 8 + wave, NGW = gridDim.x * 8;
    for (int m = gw; m < M; m += 2 * NGW) {
        const int m2 = m + NGW; const bool two = m2 < M; const int mb2 = two ? m2 : m;
        f32x4 va[4], vb[4]; float sa = 0.f, sb = 0.f;
#pragma unroll
        for (int j = 0; j < 2; ++j) {
            const u32x4 a = *(const u32x4*)(src + (size_t)m * D + 8 * (64 * j + lane)), b = *(const u32x4*)(src + (size_t)mb2 * D + 8 * (64 * j + lane));
            u32x2 t; t.x = a.x; t.y = a.y; va[2 * j] = bf4(t); t.x = a.z; t.y = a.w; va[2 * j + 1] = bf4(t);
            t.x = b.x; t.y = b.y; vb[2 * j] = bf4(t); t.x = b.z; t.y = b.w; vb[2 * j + 1] = bf4(t);
        }
#pragma unroll
        for (int j = 0; j < 4; ++j) { sa += (va[j][0] * va[j][0] + va[j][1] * va[j][1]) + (va[j][2] * va[j][2] + va[j][3] * va[j][3]); sb += (vb[j][0] * vb[j][0] + vb[j][1] * vb[j][1]) + (vb[j][2] * vb[j][2] + vb[j][3] * vb[j][3]); }
#pragma unroll
        for (int o = 1; o < 64; o <<= 1) { sa += __shfl_xor(sa, o); sb += __shfl_xor(sb, o); }
        norm_row16_finish(m, va, sa, gain, mod, shofs, scofs, XN, lane);
        if (two) norm_row16_finish(m2, vb, sb, gain, mod, shofs, scofs, XN, lane);
    }
}

DI void sb_tile(f32x16& O0, f32x16& O1, float& carry, const bf16x8 (&qf)[4], const bf16x8 (&kf)[4], const bf16x8 (&vf)[2][2], bool diag, int lane) {
    f32x16 S;
#pragma unroll
    for (int i = 0; i < 16; ++i) S[i] = 0.f;
#pragma unroll
    for (int ks = 0; ks < 4; ++ks) S = MFMA32(kf[ks], qf[ks], S);
    const int h = lane >> 5, qn = lane & 31;
    float beta[16], ein[16], G[4];
#pragma unroll
    for (int g = 0; g < 4; ++g) {
        float av[4];
#pragma unroll
        for (int r = 0; r < 4; ++r) {
            const int i = 4 * g + r;
            const float z = __builtin_fmaxf(S[i], -100.f);
            const float t = ex2(-z);
            float b = __builtin_amdgcn_rcpf(1.f + t), a = t * b;
            if (diag) { const bool ok = (8 * g + 4 * h + r) < qn; b = ok ? b : 0.f; a = ok ? a : 1.f; }
            beta[i] = b; av[r] = a;
        }
        ein[4 * g + 3] = 1.f; ein[4 * g + 2] = av[3]; ein[4 * g + 1] = av[3] * av[2]; ein[4 * g] = ein[4 * g + 1] * av[1]; G[g] = ein[4 * g] * av[0];
    }
    float Go[4], PP[4], later[4];
#pragma unroll
    for (int g = 0; g < 4; ++g) { Go[g] = __shfl_xor(G[g], 32); PP[g] = G[g] * Go[g]; }
    later[3] = carry; later[2] = later[3] * PP[3]; later[1] = later[2] * PP[2]; later[0] = later[1] * PP[1];
    carry = later[0] * PP[0];
    f32x16 W;
#pragma unroll
    for (int g = 0; g < 4; ++g) {
        const float lt = later[g] * (h == 0 ? Go[g] : 1.f);
#pragma unroll
        for (int r = 0; r < 4; ++r) W[4 * g + r] = beta[4 * g + r] * ein[4 * g + r] * lt;
    }
#pragma unroll
    for (int s = 0; s < 2; ++s) { const bf16x8 wb = pack8(W, s); O0 = MFMA32(vf[0][s], wb, O0); O1 = MFMA32(vf[1][s], wb, O1); }
}
DI void sb_item(int item, const Args& a, int lane) {
    unsigned char* ws = a.ws;
    const bf16_t* SBQ = (const bf16_t*)(ws + WS_SBQ); const bf16_t* SBK = (const bf16_t*)(ws + WS_SBK); const bf16_t* SBVT = (const bf16_t*)(ws + WS_SBVT);
    bf16_t* MIX = (bf16_t*)(ws + WS_MIX);
    const int head = item & 7, gt = item >> 3, row0 = gt * 32, h = lane >> 5, ln = lane & 31;
    bf16x8 qf[4];
#pragma unroll
    for (int ks = 0; ks < 4; ++ks) qf[ks] = ld8(SBQ + (size_t)(row0 + ln) * 512 + head * 64 + 16 * ks + 8 * h);
    f32x16 O0, O1;
#pragma unroll
    for (int i = 0; i < 16; ++i) { O0[i] = 0.f; O1[i] = 0.f; }
    float carry = 1.f;
    const bool prompt = row0 < MP;
    const int gt_last = prompt ? (gt & ~255) : (gt & ~1);
    bool done = false;
    {
        bf16x8 kf[4], vf[2][2];
#pragma unroll
        for (int ks = 0; ks < 4; ++ks) kf[ks] = ld8(SBK + (size_t)(gt * 32 + ln) * 512 + head * 64 + 16 * ks + 8 * h);
#pragma unroll
        for (int ds = 0; ds < 2; ++ds)
#pragma unroll
            for (int s = 0; s < 2; ++s) vf[ds][s] = ld44(SBVT + (((size_t)(gt * 8 + head) * 4 + 2 * s) * 64 + 32 * ds + ln) * 8 + 4 * h, 512);
        for (int kt = gt;; --kt) {
            const bool more = kt > gt_last;
            bf16x8 kn[4], vn[2][2];
            const int kp = more ? kt - 1 : kt;
#pragma unroll
            for (int ks = 0; ks < 4; ++ks) kn[ks] = ld8(SBK + (size_t)(kp * 32 + ln) * 512 + head * 64 + 16 * ks + 8 * h);
#pragma unroll
            for (int ds = 0; ds < 2; ++ds)
#pragma unroll
                for (int s = 0; s < 2; ++s) vn[ds][s] = ld44(SBVT + (((size_t)(kp * 8 + head) * 4 + 2 * s) * 64 + 32 * ds + ln) * 8 + 4 * h, 512);
            __builtin_amdgcn_sched_barrier(0);
            sb_tile(O0, O1, carry, qf, kf, vf, kt == gt, lane);
            asm volatile("" :: "v"(kn[0]), "v"(kn[1]), "v"(kn[2]), "v"(kn[3]), "v"(vn[0][0]), "v"(vn[0][1]), "v"(vn[1][0]), "v"(vn[1][1]));
            if (__all(carry < SB_EXIT)) { done = true; break; }
            if (!more) break;
#pragma unroll
            for (int ks = 0; ks < 4; ++ks) kf[ks] = kn[ks];
#pragma unroll
            for (int ds = 0; ds < 2; ++ds)
#pragma unroll
                for (int s = 0; s < 2; ++s) vf[ds][s] = vn[ds][s];
        }
    }
    if (!prompt && !done) {
        const int bs = (row0 - MP) >> 6;
        const float* ck = a.in[2] + (size_t)bs * 2048 * 512 + head * 64;
        const float* cv = a.in[3] + (size_t)bs * 2048 * 512 + head * 64;
        for (int t0 = 2048 - 32; t0 >= 0; t0 -= 32) {
            bf16x8 kf[4], vf[2][2];
#pragma unroll
            for (int ks = 0; ks < 4; ++ks) {
                const f32x4* p = (const f32x4*)(ck + (size_t)(t0 + ln) * 512 + 16 * ks + 8 * h);
                const f32x4 x0 = p[0], x1 = p[1];
                u32x4 w; w.x = pk2(x0[0], x0[1]); w.y = pk2(x0[2], x0[3]); w.z = pk2(x1[0], x1[1]); w.w = pk2(x1[2], x1[3]);
                kf[ks] = __builtin_bit_cast(bf16x8, w);
            }
#pragma unroll
            for (int ds = 0; ds < 2; ++ds)
#pragma unroll
                for (int s = 0; s < 2; ++s) {
                    float x[8];
#pragma unroll
                    for (int j = 0; j < 8; ++j) x[j] = cv[(size_t)(t0 + 16 * s + 8 * (j >> 2) + 4 * h + (j & 3)) * 512 + 32 * ds + ln];
                    u32x4 w; w.x = pk2(x[0], x[1]); w.y = pk2(x[2], x[3]); w.z = pk2(x[4], x[5]); w.w = pk2(x[6], x[7]);
                    vf[ds][s] = __builtin_bit_cast(bf16x8, w);
                }
            sb_tile(O0, O1, carry, qf, kf, vf, false, lane);
            if (__all(carry < SB_EXIT)) break;
        }
    }
    bf16_t* op = MIX + (size_t)(row0 + ln) * D + head * 64 + 4 * h;
#pragma unroll
    for (int g = 0; g < 4; ++g) {
        u32x2 w0, w1; w0.x = pk2(O0[4 * g], O0[4 * g + 1]); w0.y = pk2(O0[4 * g + 2], O0[4 * g + 3]); w1.x = pk2(O1[4 * g], O1[4 * g + 1]); w1.y = pk2(O1[4 * g + 2], O1[4 * g + 3]);
        *(u32x2*)(op + 8 * g) = w0; *(u32x2*)(op + 32 + 8 * g) = w1;
    }
}

DI void ret_update(f32x16 (&T)[4], const bf16_t* kt, const bf16_t* vt, float c, int slice, int lane) {
    const int h = lane >> 5, ln = lane & 31;
    bf16x8 vfr[4];
#pragma unroll
    for (int ks = 0; ks < 4; ++ks) vfr[ks] = ld8(vt + ((size_t)(2 * ks + h) * 128 + 32 * slice + ln) * 8);
#pragma unroll
    for (int ms = 0; ms < 4; ++ms) {
        T[ms] = T[ms] * c;
#pragma unroll
        for (int ks = 0; ks < 4; ++ks) T[ms] = MFMA32(ld8(kt + ((size_t)(2 * ks + h) * 128 + 32 * ms + ln) * 8), vfr[ks], T[ms]);
    }
}
DI void ret_loadA(bf16x8 (&kfr)[4][4], bf16x8 (&vfr)[4], const bf16_t* kt, const bf16_t* vt, int slice, int lane) {
    const int h = lane >> 5, ln = lane & 31;
#pragma unroll
    for (int ks = 0; ks < 4; ++ks) vfr[ks] = ld8(vt + ((size_t)(2 * ks + h) * 128 + 32 * slice + ln) * 8);
#pragma unroll
    for (int ms = 0; ms < 4; ++ms)
#pragma unroll
        for (int ks = 0; ks < 4; ++ks) kfr[ms][ks] = ld8(kt + ((size_t)(2 * ks + h) * 128 + 32 * ms + ln) * 8);
}
DI void ret_passA(int item, unsigned char* ws, int lane) {
    const int slice = item & 3, g = (item >> 2) % (NG - 1), bh = item / (4 * (NG - 1)), b = bh >> 2, head = bh & 3;
    const float c = ex2(64.f * lg_gamma(head));
    f32x16 T[4];
#pragma unroll
    for (int ms = 0; ms < 4; ++ms)
#pragma unroll
        for (int i = 0; i < 16; ++i) T[ms][i] = 0.f;
    const size_t cg0 = (size_t)(b * 128 + g * CG);
    const bf16_t* KT = (const bf16_t*)(ws + WS_RKT); const bf16_t* VT = (const bf16_t*)(ws + WS_RVT);
    bf16x8 kfr[4][4], vfr[4];
    ret_loadA(kfr, vfr, KT + (cg0 * 4 + head) * 8192, VT + (cg0 * 4 + head) * 8192, slice, lane);
    for (int step = 0; step < CG; ++step) {
        bf16x8 kn[4][4], vn[4];
        const size_t cgn = cg0 + (step < CG - 1 ? step + 1 : step);
        ret_loadA(kn, vn, KT + (cgn * 4 + head) * 8192, VT + (cgn * 4 + head) * 8192, slice, lane);
#pragma unroll
        for (int ms = 0; ms < 4; ++ms) {
            T[ms] = T[ms] * c;
#pragma unroll
            for (int ks = 0; ks < 4; ++ks) T[ms] = MFMA32(kfr[ms][ks], vfr[ks], T[ms]);
        }
#pragma unroll
        for (int ks = 0; ks < 4; ++ks) { vfr[ks] = vn[ks];
#pragma unroll
            for (int ms = 0; ms < 4; ++ms) kfr[ms][ks] = kn[ms][ks]; }
    }
    float* o = (float*)(ws + WS_LT) + (size_t)item * 4096;
#pragma unroll
    for (int ms = 0; ms < 4; ++ms)
#pragma unroll
        for (int i = 0; i < 16; ++i) o[(ms * 16 + i) * 64 + lane] = T[ms][i];
}
constexpr int RB_Q = 0, RB_K = 17408, RB_KT = 34816, RB_VT = 51200, RB_BYTES = 67584, RB_ROW = 272, RB_STATS = 2 * RB_BYTES;
DI bf16x8 lds8(const LAS unsigned char* p) { return *(const LAS bf16x8*)p; }
DI bf16x8 lds44(const LAS unsigned char* p, int stride_bytes) {
    const s16x4 lo = *(const LAS s16x4*)p, hi = *(const LAS s16x4*)(p + stride_bytes);
    return __builtin_shufflevector(lo, hi, 0, 1, 2, 3, 4, 5, 6, 7);
}
DI void ret_stage_load(u32x4 (&r)[16], const bf16_t* RQ, const bf16_t* RK, const bf16_t* kt, const bf16_t* vt, int rc, int head, int t) {
#pragma unroll
    for (int i = 0; i < 4; ++i) { const int q = t + 256 * i; r[i] = *(const u32x4*)(RQ + (size_t)(rc + (q >> 4)) * 512 + head * 128 + (q & 15) * 8); }
#pragma unroll
    for (int i = 0; i < 4; ++i) { const int q = t + 256 * i; r[4 + i] = *(const u32x4*)(RK + (size_t)(rc + (q >> 4)) * 512 + head * 128 + (q & 15) * 8); }
#pragma unroll
    for (int i = 0; i < 4; ++i) { const int q = t + 256 * i; r[8 + i] = *(const u32x4*)(kt + (size_t)q * 8); }
#pragma unroll
    for (int i = 0; i < 4; ++i) { const int q = t + 256 * i; r[12 + i] = *(const u32x4*)(vt + (size_t)q * 8); }
}
DI void ret_stage_store(const u32x4 (&r)[16], LAS unsigned char* buf, int t) {
#pragma unroll
    for (int i = 0; i < 4; ++i) { const int q = t + 256 * i; *(LAS u32x4*)(buf + RB_Q + (q >> 4) * RB_ROW + (q & 15) * 16) = r[i]; }
#pragma unroll
    for (int i = 0; i < 4; ++i) { const int q = t + 256 * i; *(LAS u32x4*)(buf + RB_K + (q >> 4) * RB_ROW + (q & 15) * 16) = r[4 + i]; }
#pragma unroll
    for (int i = 0; i < 4; ++i) { const int q = t + 256 * i; *(LAS u32x4*)(buf + RB_KT + q * 16) = r[8 + i]; }
#pragma unroll
    for (int i = 0; i < 4; ++i) { const int q = t + 256 * i; *(LAS u32x4*)(buf + RB_VT + q * 16) = r[12 + i]; }
}
DI void ret_block(int mode, int ci, const Args& a, LAS unsigned char* lds, int tid, int wave, int lane) {
    unsigned char* ws = a.ws;
    const bf16_t* RQ = (const bf16_t*)(ws + WS_RQ); const bf16_t* RK = (const bf16_t*)(ws + WS_RK);
    int head, row0, nsteps;
    if (mode == 0) { const int bh = ci / NG, g = ci % NG, b = bh >> 2; head = bh & 3; row0 = b * 8192 + g * (64 * CG); nsteps = CG; }
    else { const int bs = ci >> 2; head = ci & 3; row0 = MP + 64 * bs; nsteps = 1; }
    if (wave >= 4) {
        const int lt_ = tid - 256;
        {
            u32x4 r[16]; const size_t cgk = (size_t)(row0 >> 6);
            ret_stage_load(r, RQ, RK, (const bf16_t*)(ws + WS_RKT) + (cgk * 4 + head) * 8192, (const bf16_t*)(ws + WS_RVT) + (cgk * 4 + head) * 8192, row0, head, lt_);
            ret_stage_store(r, lds, lt_);
        }
        __syncthreads();
        for (int step = 0; step < nsteps; ++step) {
            const int rc = row0 + 64 * step;
            LAS unsigned char* nxt = lds + ((step + 1) & 1) * RB_BYTES;
            u32x4 r[16];
            const bool more = step + 1 < nsteps;
            if (more) {
                const size_t cgk = (size_t)((rc + 64) >> 6);
                ret_stage_load(r, RQ, RK, (const bf16_t*)(ws + WS_RKT) + (cgk * 4 + head) * 8192, (const bf16_t*)(ws + WS_RVT) + (cgk * 4 + head) * 8192, rc + 64, head, lt_);
            }
            __syncthreads();
            if (more) ret_stage_store(r, nxt, lt_);
            __syncthreads();
        }
        return;
    }
    const int slice = wave & 3, h = lane >> 5, ln = lane & 31;
    const bf16_t* RG = (const bf16_t*)(ws + WS_RG);
    bf16_t* MIX = (bf16_t*)(ws + WS_MIX);
    LAS float* stats = (LAS float*)(lds + RB_STATS);
    float* sout;
    f32x16 T[4];
    if (mode == 0) {
        const int bh = ci / NG, g = ci % NG;
        sout = (g == NG - 1) ? a.out + O_SP + (size_t)bh * 16384 : nullptr;
        const float c16 = ex2((float)(64 * CG) * lg_gamma(head));
#pragma unroll
        for (int ms = 0; ms < 4; ++ms)
#pragma unroll
            for (int i = 0; i < 16; ++i) T[ms][i] = 0.f;
        if (g > 0) {
            const float* lt0 = (const float*)(ws + WS_LT) + (size_t)((bh * (NG - 1)) * 4 + slice) * 4096 + lane;
            f32x16 L[4];
#pragma unroll
            for (int ms = 0; ms < 4; ++ms)
#pragma unroll
                for (int i = 0; i < 16; ++i) L[ms][i] = lt0[(ms * 16 + i) * 64];
            for (int gp = 0; gp < g; ++gp) {
                f32x16 N[4];
                const float* ltn = lt0 + (size_t)((gp + 1 < g ? gp + 1 : gp) * 4) * 4096;
#pragma unroll
                for (int ms = 0; ms < 4; ++ms)
#pragma unroll
                    for (int i = 0; i < 16; ++i) N[ms][i] = ltn[(ms * 16 + i) * 64];
#pragma unroll
                for (int ms = 0; ms < 4; ++ms) { T[ms] = T[ms] * c16 + L[ms]; L[ms] = N[ms]; }
            }
        }
    } else {
        sout = a.out + O_SS + (size_t)ci * 16384;
        const float* s0 = a.in[4] + (size_t)ci * 16384;
        const float ig = ex2(-63.f * lg_gamma(head));
#pragma unroll
        for (int ms = 0; ms < 4; ++ms)
#pragma unroll
            for (int i = 0; i < 16; ++i) T[ms][i] = s0[(32 * ms + 8 * (i >> 2) + 4 * h + (i & 3)) * 128 + 32 * slice + ln] * ig;
    }
    const float c = ex2(64.f * lg_gamma(head));
    __syncthreads();
    for (int step = 0; step < nsteps; ++step) {
        const int rc = row0 + 64 * step;
        const LAS unsigned char* cur = lds + (step & 1) * RB_BYTES;
        LAS float* st = stats + (step & 1) * 512;
        f32x16 out[2]; u32x2 gt[2][4];
#pragma unroll
        for (int is = 0; is < 2; ++is)
#pragma unroll
            for (int g4 = 0; g4 < 4; ++g4) gt[is][g4] = *(const u32x2*)(RG + (size_t)(rc + 32 * is + ln) * 512 + head * 128 + 32 * slice + 8 * g4 + 4 * h);
#pragma unroll
        for (int is = 0; is < 2; ++is)
#pragma unroll
            for (int i = 0; i < 16; ++i) out[is][i] = 0.f;
        const LAS unsigned char* qrow = cur + RB_Q + ln * RB_ROW; const LAS unsigned char* krow = cur + RB_K + ln * RB_ROW;
#pragma unroll
        for (int ms = 0; ms < 4; ++ms)
#pragma unroll
            for (int s = 0; s < 2; ++s) {
                const bf16x8 tb = pack8(T[ms], s);
#pragma unroll
                for (int is = 0; is < 2; ++is) out[is] = MFMA32(tb, lds44(qrow + is * 32 * RB_ROW + (32 * ms + 16 * s + 4 * h) * 2, 16), out[is]);
            }
#pragma unroll
        for (int is = 0; is < 2; ++is) out[is] = out[is] * c;
#pragma unroll
        for (int blk = 0; blk < 3; ++blk) {
            const int js = blk == 2 ? 1 : 0, is = blk == 0 ? 0 : 1;
            f32x16 P;
#pragma unroll
            for (int i = 0; i < 16; ++i) P[i] = 0.f;
#pragma unroll
            for (int ks = 0; ks < 8; ++ks) P = MFMA32(lds8(krow + js * 32 * RB_ROW + (16 * ks + 8 * h) * 2), lds8(qrow + is * 32 * RB_ROW + (16 * ks + 8 * h) * 2), P);
            if (js == is) {
#pragma unroll
                for (int i = 0; i < 16; ++i) P[i] = (8 * (i >> 2) + 4 * h + (i & 3)) <= ln ? P[i] : 0.f;
            }
#pragma unroll
            for (int s = 0; s < 2; ++s) out[is] = MFMA32(lds44(cur + RB_VT + ((4 * js + 2 * s) * 128 + 32 * slice + ln) * 16 + 8 * h, 2048), pack8(P, s), out[is]);
        }
        {
            bf16x8 vfr[4];
#pragma unroll
            for (int ks = 0; ks < 4; ++ks) vfr[ks] = lds8(cur + RB_VT + ((2 * ks + h) * 128 + 32 * slice + ln) * 16);
#pragma unroll
            for (int ms = 0; ms < 4; ++ms) {
                T[ms] = T[ms] * c;
#pragma unroll
                for (int ks = 0; ks < 4; ++ks) T[ms] = MFMA32(lds8(cur + RB_KT + ((2 * ks + h) * 128 + 32 * ms + ln) * 16), vfr[ks], T[ms]);
            }
        }
#pragma unroll
        for (int is = 0; is < 2; ++is) {
            float s1 = 0.f, s2 = 0.f;
#pragma unroll
            for (int i = 0; i < 16; ++i) { s1 += out[is][i]; s2 += out[is][i] * out[is][i]; }
            s1 += __shfl_xor(s1, 32); s2 += __shfl_xor(s2, 32);
            if (h == 0) { st[slice * 128 + 2 * (32 * is + ln)] = s1; st[slice * 128 + 2 * (32 * is + ln) + 1] = s2; }
        }
        __syncthreads();
#pragma unroll
        for (int is = 0; is < 2; ++is) {
            float t1 = 0.f, t2 = 0.f;
#pragma unroll
            for (int sl = 0; sl < 4; ++sl) { t1 += st[sl * 128 + 2 * (32 * is + ln)]; t2 += st[sl * 128 + 2 * (32 * is + ln) + 1]; }
            const float mean = t1 * (1.f / 128.f), var = __builtin_fmaxf(t2 * (1.f / 128.f) - mean * mean, 0.f), rstd = __builtin_amdgcn_rsqf(var + EPS);
            const size_t row = (size_t)(rc + 32 * is + ln);
#pragma unroll
            for (int g4 = 0; g4 < 4; ++g4) {
                const int d0 = 32 * slice + 8 * g4 + 4 * h;
                const u32x2 gg = gt[is][g4];
                const float g0 = __builtin_bit_cast(float, gg.x << 16), g1 = __builtin_bit_cast(float, gg.x & 0xffff0000u), g2 = __builtin_bit_cast(float, gg.y << 16), g3 = __builtin_bit_cast(float, gg.y & 0xffff0000u);
                u32x2 w; w.x = pk2((out[is][4 * g4] - mean) * rstd * g0, (out[is][4 * g4 + 1] - mean) * rstd * g1);
                w.y = pk2((out[is][4 * g4 + 2] - mean) * rstd * g2, (out[is][4 * g4 + 3] - mean) * rstd * g3);
                *(u32x2*)(MIX + row * D + 512 + head * 128 + d0) = w;
            }
        }
        __syncthreads();
    }
    if (sout) {
        const float gsc = ex2(63.f * lg_gamma(head));
#pragma unroll
        for (int ms = 0; ms < 4; ++ms)
#pragma unroll
            for (int i = 0; i < 16; ++i) sout[(32 * ms + 8 * (i >> 2) + 4 * h + (i & 3)) * 128 + 32 * slice + ln] = T[ms][i] * gsc;
    }
}

#define RLX_AGENT __ATOMIC_RELAXED, __HIP_MEMORY_SCOPE_AGENT
#define XB_TMO      128
#define XB_XCNT(j)  (256  + 64 * (j))
#define XB_XSUB(j)  (1280 + 64 * (j))
#define XB_XGEN(j)  (2304 + 64 * (j))
#define XB_TOP      3328
#define XB_TOPGEN   3392
#define XCD_BAR_WORDS 3456
#define XB_SPIN_CAP (1u << 18)

__device__ __forceinline__ unsigned xb_ld(unsigned* p)              { return __hip_atomic_load(p, __ATOMIC_RELAXED, __HIP_MEMORY_SCOPE_AGENT); }
__device__ __forceinline__ unsigned xb_add(unsigned* p, unsigned v) { return __hip_atomic_fetch_add(p, v, __ATOMIC_RELAXED, __HIP_MEMORY_SCOPE_AGENT); }
__device__ __forceinline__ unsigned xb_xcc_id() { return (unsigned)__builtin_amdgcn_s_getreg((3 << 11) | 20) & 0xFu; }
#define XB_SPIN(cond, bar) do { unsigned _sp = 0; while (cond) { __builtin_amdgcn_s_sleep(1); \
    if ((++_sp & 255u) == 0u) { if (xb_ld(&(bar)[XB_TMO])) break; if (_sp > XB_SPIN_CAP) { atomicAdd(&(bar)[XB_TMO], 1u); break; } } } } while (0)

struct XcdBarrier {
    unsigned* bar; unsigned x;
    volatile LAS unsigned* st;
};

__device__ __forceinline__ XcdBarrier xcd_barrier_post(unsigned* bar, volatile LAS unsigned* st) {
    XcdBarrier b; b.bar = bar; b.x = xb_xcc_id(); b.st = st;
    if (threadIdx.x == 0) (void)xb_add(&bar[XB_XCNT(b.x)], 1u);
    return b;
}
__device__ __forceinline__ void xcd_barrier_complete(unsigned* bar, unsigned x, unsigned& nloc, unsigned& nx) {
    const unsigned G = gridDim.x * gridDim.y * gridDim.z;
    unsigned sum, cnt, mine, sp = 0u;
    for (;;) {
        sum = 0u; cnt = 0u; mine = 0u;
#pragma unroll
        for (unsigned j = 0; j < 16; ++j) { const unsigned c = xb_ld(&bar[XB_XCNT(j)]); sum += c; cnt += (c > 0u) ? 1u : 0u; mine = (j == x) ? c : mine; }
        if (sum == G) break;
        __builtin_amdgcn_s_sleep(1);
        if ((++sp & 255u) == 0u) { if (xb_ld(&bar[XB_TMO])) break; if (sp > XB_SPIN_CAP) { atomicAdd(&bar[XB_TMO], 1u); break; } }
    }
    nloc = mine > 0u ? mine : 1u; nx = cnt > 0u ? cnt : 1u;
}

__device__ __forceinline__ void xcd_barrier(const XcdBarrier& b) {
    asm volatile("s_waitcnt vmcnt(0)" ::: "memory");
    __syncthreads();
    if (threadIdx.x == 0) {
        unsigned* bar = b.bar;
        __builtin_amdgcn_s_waitcnt(0);
        unsigned nloc = b.st[0], nx = b.st[1];
        if (nloc == 0u) { xcd_barrier_complete(bar, b.x, nloc, nx); b.st[0] = nloc; b.st[1] = nx; }
        const unsigned old = xb_add(&bar[XB_XSUB(b.x)], 1u);
        const unsigned gen = old / nloc;
        if (old + 1u == (gen + 1u) * nloc) {
            __builtin_amdgcn_fence(__ATOMIC_RELEASE, "agent");
            asm volatile("s_waitcnt vmcnt(0)" ::: "memory");
            const unsigned og = xb_add(&bar[XB_TOP], 1u);
            const unsigned tg = og / nx;
            if (og + 1u == (tg + 1u) * nx) xb_add(&bar[XB_TOPGEN], 1u);
            else XB_SPIN(xb_ld(&bar[XB_TOPGEN]) == tg, bar);
            __builtin_amdgcn_fence(__ATOMIC_ACQUIRE, "agent");
            xb_add(&bar[XB_XGEN(b.x)], 1u);
            asm volatile("s_waitcnt vmcnt(0)" ::: "memory");
        } else {
            XB_SPIN(xb_ld(&bar[XB_XGEN(b.x)]) == gen, bar);
            __builtin_amdgcn_fence(__ATOMIC_ACQUIRE, "agent");
            asm volatile("s_waitcnt vmcnt(0)" ::: "memory");
        }
    }
    __syncthreads();
}

__global__ void __launch_bounds__(512, 2) fwd(Args a) {
    extern __shared__ __attribute__((aligned(16))) unsigned char lds_raw[];
    LAS unsigned char* lds = (LAS unsigned char*)lds_raw;
    cg::grid_group grid = cg::this_grid();
    const int tid0 = threadIdx.x;
    unsigned char* ws = a.ws;
    volatile LAS unsigned* bst = (volatile LAS unsigned*)(lds + LDS_BYTES - 64);
    if (tid0 < 2) bst[tid0] = 0u;
    __syncthreads();
    XcdBarrier bar; bar.bar = (unsigned*)(ws + WS_BAR); bar.x = 0; bar.st = bst;
    float* mod = (float*)(ws + WS_MOD);
    bf16_t* XN = (bf16_t*)(ws + WS_XN);
    constexpr int NPI = 12 + (PH_DUP >= 0 ? 1 : 0);
    for (int pi = 0; pi < NPI; ++pi) {
        const int ph = (PH_DUP >= 0 && pi > PH_DUP) ? pi - 1 : pi;
        int tid = tid0; asm volatile("" : "+v"(tid));
        const int lane = tid & 63, wave = __builtin_amdgcn_readfirstlane(tid >> 6);
        if (ph == 0 && PHON(0)) {
            p0_prologue(a, lds, tid, wave, lane, pi == 0);
        } else if ((ph == 1 || ph == 4 || ph == 9) && PHON(1)) {
            const float* sP = ph == 1 ? a.in[0] : a.out; const float* sS = ph == 1 ? a.in[1] : a.out + (size_t)MP * D;
            const float* gain = ph == 1 ? a.in[9] : ph == 4 ? a.in[10] : a.in[11];
            const int k = ph == 1 ? 0 : ph == 4 ? 3 : 6;
            if (ph == 1) norm_phase(sP, sS, nullptr, gain, mod, k * D, (k + 1) * D, XN, wave, lane);
            else norm_phase_b16((const bf16_t*)(ws + WS_XB), gain, mod, k * D, (k + 1) * D, XN, wave, lane);
        } else if ((ph == 2 || ph == 10) && PHON(2)) {
            pg8::Gemm g{XN, (const bf16_t*)(ws + (ph == 2 ? WS_WUP1 : WS_WUP2)), M, NUP, D, 0}; pg8::StaticOrder S; S.init(M, NUP, D, (int)gridDim.x, (int)blockIdx.x);
            EpiSwiGLU E{(bf16_t*)(ws + WS_ACT)};
            pg8::gemm_phase<EpiSwiGLU, pg8::StaticOrder, true, true>(lds, g, S, E);
        } else if ((ph == 3 || ph == 8 || ph == 11) && PHON(3)) {
            const bf16_t* A = (const bf16_t*)(ws + (ph == 8 ? WS_MIX : WS_ACT));
            const bf16_t* W = (const bf16_t*)(ws + (ph == 3 ? WS_WDN1 : ph == 8 ? WS_WOUT : WS_WDN2));
            pg8::Gemm g{A, W, M, D, ph == 8 ? D : FF, ph == 8 ? 0 : 1}; pg8::StaticOrder S; S.init(M, D, ph == 8 ? D : FF, (int)gridDim.x, (int)blockIdx.x);
            EpiResid E{a.in[0], a.in[1], a.out, mod, (ph == 3 ? 2 : ph == 8 ? 5 : 8) * D, ph == 8 ? 1.f : 0.5f, ph == 3 ? 0 : ph == 8 ? 1 : 2};
            pg8::gemm_phase<EpiResid, pg8::StaticOrder, true, true>(lds, g, S, E);
        } else if (ph == 5 && PHON(5)) {
            pg8::Gemm g{XN, (const bf16_t*)(ws + WS_WIN), M, NIN, D, 0}; pg8::StaticOrder S; S.init(M, NIN, D, (int)gridDim.x, (int)blockIdx.x);
            EpiIn E{a.in[15], a.in[16], (const f32x2*)(ws + WS_ROPE), a.out, ws};
            pg8::gemm_phase<EpiIn, pg8::StaticOrder, true, true>(lds, g, S, E);
        } else if (ph == 6 && PHON(6)) {
            unsigned* q = (unsigned*)(ws + WS_CTL) + 64 + 512 * (pi & 1);
            const int x0 = (int)(xb_xcc_id() & 7u);
            constexpr int QS = 64, QA = (16 * (NG - 1) * 4) / 8, QP = (MP / 32) * 8 / 8, QN = QS + QA + QP;
            for (int dx = 0; dx < 8; ++dx) {
                const int x = (x0 + dx) & 7;
                for (;;) {
                    unsigned k = 0;
                    if (lane == 0) k = __hip_atomic_fetch_add(q + 64 * x, 1u, __ATOMIC_RELAXED, __HIP_MEMORY_SCOPE_AGENT);
                    k = (unsigned)__builtin_amdgcn_readfirstlane((int)k);
                    if (k >= (unsigned)QN) break;
                    if (k >= (unsigned)QS && k < (unsigned)(QS + QA)) ret_passA(x * QA + (int)k - QS, ws, lane);
                    else sb_item(k < (unsigned)QS ? (MP / 32) * 8 + x * QS + (int)k : x * QP + (int)k - (QS + QA), a, lane);
                }
            }
        } else if (ph == 7 && PHON(7)) {
            const int G = (int)gridDim.x, nit = 16 * NG + 128;
            for (int k = 0;; ++k) {
                int bi;
                if (G == 16 * NG) { const int g = (int)blockIdx.x % NG; if (k == 0) bi = (int)blockIdx.x; else if (k == 1 && g < NG / 2) bi = 16 * NG + ((int)blockIdx.x / NG) * (NG / 2) + g; else break; }
                else { bi = (int)blockIdx.x + k * G; if (bi >= nit) break; }
                ret_block(bi >= 16 * NG, bi >= 16 * NG ? bi - 16 * NG : bi, a, lds, tid, wave, lane);
            }
        }
        if (pi == 0) { grid.sync(); bar = xcd_barrier_post((unsigned*)(ws + WS_BAR), bst); }
        else if (pi < NPI - 1) xcd_barrier(bar);
        if (PHREP(12)) xcd_barrier(bar);
    }
}
}

extern "C" void kernel_launch(void* const* d_in, const int* in_sizes, int n_in, void* d_out, int out_size, void* d_ws, size_t ws_size, hipStream_t stream) {
    static int grid = 0;
    if (grid == 0) {
        if (n_in != 20 || ws_size < mk::WS_END) { fprintf(stderr, "kernel_launch: unexpected inputs (n_in %d, ws %zu)\n", n_in, ws_size); grid = -1; return; }
        int dev = 0, cus = 0, per_cu = 0;
        hipGetDevice(&dev);
        hipDeviceGetAttribute(&cus, hipDeviceAttributeMultiprocessorCount, dev);
        hipFuncSetAttribute((const void*)mk::fwd, hipFuncAttributeMaxDynamicSharedMemorySize, mk::LDS_BYTES);
        hipOccupancyMaxActiveBlocksPerMultiprocessor(&per_cu, (const void*)mk::fwd, 512, mk::LDS_BYTES);
        if (per_cu < 1) per_cu = 1;
        grid = cus * per_cu;
        (void)hipGetLastError();
    }
    if (grid < 0) return;
    mk::Args a{};
    for (int i = 0; i < 20; ++i) a.in[i] = (const float*)d_in[i];
    a.out = (float*)d_out; a.ws = (unsigned char*)d_ws;
    void* args[] = {&a};
    hipError_t e = hipLaunchCooperativeKernel((const void*)mk::fwd, dim3(grid), dim3(512), args, mk::LDS_BYTES, stream);
    if (e != hipSuccess) fprintf(stderr, "cooperative launch failed: %s (grid %d)\n", hipGetErrorString(e), grid);
}
```

```cpp
#include <hip/hip_runtime.h>
#include <hip/hip_cooperative_groups.h>
#include <cstdio>
#include <cstdint>
namespace cg = cooperative_groups;
namespace pg8 {
#define PG8_LAS __attribute__((address_space(3)))
typedef unsigned short bf16_t;
typedef short bf16x8 __attribute__((ext_vector_type(8)));
typedef float f32x4 __attribute__((ext_vector_type(4)));
typedef unsigned u32x4 __attribute__((ext_vector_type(4)));
constexpr int BM = 256, BK = 64, HALF = 128, HTB = HALF * BK * 2  , STAGE_BYTES = 8 * HTB, NXCD = 8, WGM = 8;

__host__ __device__ __forceinline__ int lds_byte(int r, int c) { const int st = (r >> 4) * 2 + (c >> 5), rr = r & 15, cc = c & 31, ob = rr * 64 + cc * 2; return st * 1024 + (ob ^ (((ob >> 9) & 1) << 5)); }
__host__ __device__ __forceinline__ void stage_rc(int b, int& R, int& C) { const int st = b / 1024, sb = b % 1024, swz = sb ^ (((sb >> 9) & 1) << 5); R = (st >> 1) * 16 + swz / 64; C = (st & 1) * 32 + (swz % 64) / 2; }
__host__ __device__ __forceinline__ int perm32(int rho) { const int n = rho >> 4, i = rho & 15; return 8 * (i >> 2) + 4 * n + (i & 3); }

struct Unit { int pm, pn, kt0, nkt, aux; };
struct Gemm { const bf16_t* A; const bf16_t* Bt; int M, N, K; int a_blk; };

struct StaticOrder {
    int nM, nN, nwg, G, c, nt;
    __host__ __device__ void init(int M, int N, int K, int G_, int c_) { nM = M / BM; nN = N / BM; nwg = nM * nN; G = G_; c = c_; nt = K / BK; }
    __host__ __device__ bool next(int i, Unit& u) const {
        const long L = (long)i * G + c; if (L >= nwg) return false;
        int wgid = (int)L; { const int q = nwg / NXCD, r = nwg % NXCD, xcd = wgid % NXCD, off = wgid / NXCD; wgid = (xcd < r ? xcd * (q + 1) : r * (q + 1) + (xcd - r) * q) + off; }
        const int nig = WGM * nN, gid = wgid / nig, fm = gid * WGM, gsz = (nM - fm) < WGM ? (nM - fm) : WGM;
        u.pm = fm + ((wgid % nig) % gsz); u.pn = (wgid % nig) / gsz; u.kt0 = 0; u.nkt = nt; u.aux = 0; return true;
    }
    __device__ __forceinline__ void a_ready(const Unit&) const {}
    __device__ __forceinline__ void done(const Unit&) const {}
};
__device__ __forceinline__ unsigned cvt_pk_bf16(float lo, float hi) { unsigned r; asm volatile("v_cvt_pk_bf16_f32 %0, %1, %2" : "=v"(r) : "v"(lo), "v"(hi)); return r; }
template <class Epi, class Sched, bool ALIGN_EPI = false, bool SP2 = false>
__device__ __forceinline__ void gemm_phase(PG8_LAS unsigned char* lds, const Gemm g, const Sched& S, const Epi& E) {
    int tid_ = threadIdx.x; asm volatile("" : "+v"(tid_));
    const int tid = tid_, wid = __builtin_amdgcn_readfirstlane(tid >> 6), lane = tid & 63, wr = wid >> 2, wc = wid & 3, fr = lane & 15, fq = lane >> 4;
    const int K = g.K;
    unsigned voffA[2], voffB[2];
#pragma unroll
    for (int i = 0; i < 2; ++i) { int R, C; stage_rc(tid * 16 + i * 8192, R, C); const int Rb = Epi::PERM ? ((R & ~31) + perm32(R & 31)) : R;
        voffA[i] = (unsigned)(R * (g.a_blk ? BK : K) + C) * 2u; voffB[i] = (unsigned)(Rb * K + C) * 2u; }
    const size_t kstep = (size_t)(BK * 2);
    const size_t hstep = (size_t)HALF * K * 2;
    const size_t tstep = 2 * hstep;
    const size_t kstepA = g.a_blk ? (size_t)(BM * BK * 2) : kstep, hstepA = g.a_blk ? (size_t)(HALF * BK * 2) : hstep;
    const unsigned ldsw = (unsigned)wid * 1024u;
    const int aoff = lds_byte(wr * 64 + fr, fq * 8), boff = lds_byte(wc * 32 + fr, fq * 8);
#define PG8_SA(b, h) (((b) * 2 + (h)) * HTB)
#define PG8_SB(b, h) ((4 + (b) * 2 + (h)) * HTB)
#define PG8_STAGE(bufoff, gbase, voff) do { _Pragma("unroll") for (int _i = 0; _i < 2; ++_i) \
        __builtin_amdgcn_global_load_lds((const unsigned*)((const char*)(gbase) + (voff)[_i]), (PG8_LAS unsigned*)(lds + (bufoff) + ldsw + _i * 8192), 16, 0, 0); } while (0)
#define PG8_LDA(dst, b, h) do { _Pragma("unroll") for (int m = 0; m < 4; ++m) _Pragma("unroll") for (int k = 0; k < 2; ++k) dst[m][k] = *(const PG8_LAS bf16x8*)(lds + PG8_SA(b, h) + aoff + m * 2048 + k * 1024); } while (0)
#define PG8_LDB(dst, b, h) do { _Pragma("unroll") for (int n = 0; n < 2; ++n) _Pragma("unroll") for (int k = 0; k < 2; ++k) dst[n][k] = *(const PG8_LAS bf16x8*)(lds + PG8_SB(b, h) + boff + n * 2048 + k * 1024); } while (0)
#define PG8_MMA(ai, bj, At, Bt) do { __builtin_amdgcn_s_setprio(1); _Pragma("unroll") for (int m = 0; m < 4; ++m) _Pragma("unroll") for (int n = 0; n < 2; ++n) _Pragma("unroll") for (int k = 0; k < 2; ++k) \
        acc[ai][bj][m][n] = __builtin_amdgcn_mfma_f32_16x16x32_bf16(Bt[n][k], At[m][k], acc[ai][bj][m][n], 0, 0, 0); __builtin_amdgcn_s_setprio(0); } while (0)
#define PG8_WAIT_V(n) asm volatile("s_waitcnt vmcnt(" #n ")" ::: "memory")
#define PG8_WAIT_L(n) asm volatile("s_waitcnt lgkmcnt(" #n ")" ::: "memory")
#define PG8_BAR __builtin_amdgcn_s_barrier()
#define PG8_SCHED __builtin_amdgcn_sched_barrier(0)
    Unit cur, nxt; int ui = 0;
    if (!S.next(0, cur)) return;
    f32x4 acc[2][2][4][2];
#pragma unroll
    for (int a = 0; a < 2; ++a)
#pragma unroll
        for (int b = 0; b < 2; ++b)
#pragma unroll
            for (int m = 0; m < 4; ++m)
#pragma unroll
                for (int n = 0; n < 2; ++n) acc[a][b][m][n] = (f32x4){0.f, 0.f, 0.f, 0.f};
    bf16x8 At[4][2], B0[2][2], B1[2][2];
    const char* cA = (const char*)g.A + (size_t)cur.pm * tstep + (size_t)cur.kt0 * kstepA; const char* cB = (const char*)g.Bt + (size_t)cur.pn * tstep + (size_t)cur.kt0 * kstep;
    S.a_ready(cur);
    if constexpr (SP2) {
        PG8_STAGE(PG8_SB(0, 0), cB, voffB); PG8_STAGE(PG8_SB(0, 1), cB + hstep, voffB); PG8_STAGE(PG8_SA(0, 0), cA, voffA); PG8_STAGE(PG8_SA(0, 1), cA + hstepA, voffA);
        if (wr == 1) PG8_BAR;
        PG8_WAIT_V(2); PG8_BAR;
        PG8_STAGE(PG8_SB(1, 0), cB + kstep, voffB); PG8_STAGE(PG8_SA(1, 0), cA + kstepA, voffA); PG8_STAGE(PG8_SB(1, 1), cB + hstep + kstep, voffB);
        PG8_WAIT_V(6); PG8_BAR;
    } else {
        PG8_STAGE(PG8_SB(0, 0), cB, voffB); PG8_STAGE(PG8_SA(0, 0), cA, voffA); PG8_STAGE(PG8_SB(0, 1), cB + hstep, voffB); PG8_STAGE(PG8_SA(0, 1), cA + hstepA, voffA);
        if (wr == 1) PG8_BAR;
        PG8_WAIT_V(4); PG8_BAR;
        PG8_STAGE(PG8_SB(1, 0), cB + kstep, voffB); PG8_STAGE(PG8_SA(1, 0), cA + kstepA, voffA); PG8_STAGE(PG8_SB(1, 1), cB + hstep + kstep, voffB);
        PG8_WAIT_V(6); PG8_BAR;
    }
    for (;;) {
        const bool has_next = S.next(ui + 1, nxt);
        const char* nA = has_next ? (const char*)g.A + (size_t)nxt.pm * tstep + (size_t)nxt.kt0 * kstepA : cA; const char* nB = has_next ? (const char*)g.Bt + (size_t)nxt.pn * tstep + (size_t)nxt.kt0 * kstep : cB;
        const int nt = cur.nkt;
        for (int t = 0; t < nt; t += 2) {
            const bool last = (t == nt - 2);
            const char* a1 = cA + (size_t)(t + 1) * kstepA;
            const char* a2 = last ? nA : cA + (size_t)(t + 2) * kstepA; const char* b2 = last ? nB : cB + (size_t)(t + 2) * kstep;
            const char* a3 = a2 + kstepA; const char* b3 = b2 + kstep;
            if (last && has_next) S.a_ready(nxt);
            if constexpr (SP2) {
            PG8_LDB(B0, 0, 0); PG8_LDB(B1, 0, 1); PG8_SCHED; PG8_LDA(At, 0, 0); PG8_STAGE(PG8_SA(1, 1), a1 + hstepA, voffA);
            PG8_WAIT_V(8); PG8_WAIT_L(0); PG8_BAR; PG8_MMA(0, 0, At, B0); PG8_MMA(0, 1, At, B1); PG8_BAR; PG8_SCHED;
            PG8_LDA(At, 0, 1); PG8_STAGE(PG8_SB(0, 0), b2, voffB); PG8_STAGE(PG8_SB(0, 1), b2 + hstep, voffB); PG8_STAGE(PG8_SA(0, 0), a2, voffA);
            PG8_WAIT_V(8); PG8_WAIT_L(0); PG8_BAR; PG8_MMA(1, 0, At, B0); PG8_MMA(1, 1, At, B1); PG8_BAR; PG8_SCHED;
            PG8_LDB(B0, 1, 0); PG8_LDB(B1, 1, 1); PG8_SCHED; PG8_LDA(At, 1, 0); PG8_STAGE(PG8_SA(0, 1), a2 + hstepA, voffA);
            PG8_WAIT_V(8); PG8_WAIT_L(0); PG8_BAR; PG8_MMA(0, 0, At, B0); PG8_MMA(0, 1, At, B1); PG8_BAR; PG8_SCHED;
            PG8_LDA(At, 1, 1); PG8_STAGE(PG8_SB(1, 0), b3, voffB); PG8_STAGE(PG8_SB(1, 1), b3 + hstep, voffB); PG8_STAGE(PG8_SA(1, 0), a3, voffA);
            PG8_WAIT_V(8); PG8_WAIT_L(0); PG8_BAR; PG8_MMA(1, 0, At, B0); PG8_MMA(1, 1, At, B1); PG8_BAR; PG8_SCHED;
            } else {
            PG8_LDB(B0, 0, 0); PG8_SCHED; PG8_LDA(At, 0, 0); PG8_STAGE(PG8_SA(1, 1), a1 + hstepA, voffA);
            PG8_WAIT_L(8); PG8_BAR; PG8_WAIT_L(0); PG8_MMA(0, 0, At, B0); PG8_BAR; PG8_SCHED;
            PG8_LDB(B1, 0, 1); PG8_STAGE(PG8_SB(0, 0), b2, voffB);
            PG8_BAR; PG8_WAIT_L(0); PG8_MMA(0, 1, At, B1); PG8_BAR;
            PG8_LDA(At, 0, 1); PG8_STAGE(PG8_SA(0, 0), a2, voffA);
            PG8_BAR; PG8_WAIT_L(0); PG8_MMA(1, 0, At, B0); PG8_BAR; PG8_SCHED;
            PG8_STAGE(PG8_SB(0, 1), b2 + hstep, voffB);
            PG8_WAIT_V(6); PG8_BAR; PG8_MMA(1, 1, At, B1); PG8_BAR;
            PG8_LDB(B0, 1, 0); PG8_SCHED; PG8_LDA(At, 1, 0); PG8_STAGE(PG8_SA(0, 1), a2 + hstepA, voffA);
            PG8_WAIT_L(8); PG8_BAR; PG8_WAIT_L(0); PG8_MMA(0, 0, At, B0); PG8_BAR; PG8_SCHED;
            PG8_LDB(B1, 1, 1); PG8_STAGE(PG8_SB(1, 0), b3, voffB);
            PG8_BAR; PG8_WAIT_L(0); PG8_MMA(0, 1, At, B1); PG8_BAR;
            PG8_LDA(At, 1, 1); PG8_STAGE(PG8_SA(1, 0), a3, voffA);
            PG8_BAR; PG8_WAIT_L(0); PG8_MMA(1, 0, At, B0); PG8_BAR; PG8_SCHED;
            PG8_STAGE(PG8_SB(1, 1), b3 + hstep, voffB);
            PG8_WAIT_V(6); PG8_BAR; PG8_MMA(1, 1, At, B1); PG8_BAR;
            }
        }
        if constexpr (ALIGN_EPI) { if (wr == 0) PG8_BAR; }
        if constexpr (!Epi::AFTER_DRAIN) { E(acc, cur, wr, wc, fr, fq); S.done(cur); }
        if (!has_next) break;
#pragma unroll
        for (int a = 0; a < 2; ++a)
#pragma unroll
            for (int b = 0; b < 2; ++b)
#pragma unroll
                for (int m = 0; m < 4; ++m)
#pragma unroll
                    for (int n = 0; n < 2; ++n) acc[a][b][m][n] = (f32x4){0.f, 0.f, 0.f, 0.f};
        cur = nxt; cA = nA; cB = nB; ++ui;
        if constexpr (ALIGN_EPI) { if (wr == 1) PG8_BAR; }
    }
    PG8_WAIT_V(0);
    if constexpr (!ALIGN_EPI) { if (wr == 0) PG8_BAR; }
    PG8_BAR;
    if constexpr (Epi::AFTER_DRAIN) { E.fused(acc, cur, wr, wc, fr, fq, lds, wid, lane); S.done(cur); }
#undef PG8_SA
#undef PG8_SB
#undef PG8_STAGE
#undef PG8_LDA
#undef PG8_LDB
#undef PG8_MMA
#undef PG8_WAIT_V
#undef PG8_WAIT_L
#undef PG8_BAR
#undef PG8_SCHED
}
}

namespace mk {
using pg8::bf16_t; using pg8::bf16x8; using pg8::f32x4; using pg8::u32x4; using pg8::Unit;
#define DI __device__ __forceinline__
#define LAS __attribute__((address_space(3)))
typedef short s16x4 __attribute__((ext_vector_type(4)));
typedef float f32x16 __attribute__((ext_vector_type(16)));
typedef float f32x2 __attribute__((ext_vector_type(2)));
typedef unsigned u32x2 __attribute__((ext_vector_type(2)));
typedef __bf16 bf16x2_t __attribute__((ext_vector_type(2)));
#define MFMA32(a, b, c) __builtin_amdgcn_mfma_f32_32x32x16_bf16((a), (b), (c), 0, 0, 0)

constexpr int MP = 32768, MS = 2048, M = MP + MS, D = 1024, FF = 2816, NUP = 2 * FF, NIN = 3584, NMOD = 9 * D;
constexpr float EPS = 1e-6f, LOG2E = 1.4426950408889634f;
constexpr float QSCALE = 0.18033688011112042f;
constexpr float KSCALE = 0.08838834764831845f;
constexpr float SB_EXIT = 1e-30f;

constexpr size_t MiB = 1u << 20;
constexpr size_t WS_CTL = 0, WS_BAR = 65536, WS_MOD = 1 * MiB, WS_ROPE = 4 * MiB;
constexpr size_t WS_WUP1 = 8 * MiB, WS_WDN1 = 19 * MiB, WS_WIN = 25 * MiB, WS_WOUT = 32 * MiB, WS_WUP2 = 34 * MiB, WS_WDN2 = 45 * MiB;
constexpr size_t WS_XN = 60 * MiB, WS_BIG = 128 * MiB;
constexpr size_t WS_ACT = WS_BIG;
constexpr size_t WS_SBQ = WS_BIG, WS_SBK = WS_BIG + 34 * MiB, WS_SBVT = WS_BIG + 68 * MiB, WS_RQ = WS_BIG + 102 * MiB, WS_RK = WS_BIG + 136 * MiB,
                 WS_RKT = WS_BIG + 170 * MiB, WS_RVT = WS_BIG + 204 * MiB, WS_RG = WS_BIG + 238 * MiB, WS_MIX = WS_XN  , WS_LT = WS_BIG + 272 * MiB, WS_XB = WS_BIG + 288 * MiB, WS_END = WS_BIG + 356 * MiB;
constexpr int NG = 16, CG = 8;
constexpr size_t O_Y = 0, O_KP = 35651584, O_VP = 52428800, O_SP = 69206016, O_KS = 69468160, O_VS = 70516736, O_SS = 71565312;

constexpr int LDS_BYTES = 147456;
#ifndef PH_MASK
#define PH_MASK 0xFFF
#endif
#define PHON(k) ((PH_MASK >> (k)) & 1)
#ifndef PH_REP
#define PH_REP 0
#endif
#ifndef PH_DUP
#define PH_DUP -1
#endif
#define PHREP(k) ((PH_REP >> (k)) & 1)

DI unsigned pk2(float lo, float hi) { f32x2 v = {lo, hi}; bf16x2_t b = __builtin_convertvector(v, bf16x2_t); return __builtin_bit_cast(unsigned, b); }
DI float bf2f(unsigned short s) { return __builtin_bit_cast(float, (unsigned)s << 16); }
DI f32x4 bf4(u32x2 w) { f32x4 r; r[0] = __builtin_bit_cast(float, w.x << 16); r[1] = __builtin_bit_cast(float, w.x & 0xffff0000u); r[2] = __builtin_bit_cast(float, w.y << 16); r[3] = __builtin_bit_cast(float, w.y & 0xffff0000u); return r; }
DI int row_batch(int r) { return r < MP ? (r >> 13) : 4 + ((r - MP) >> 6); }
DI int row_pos(int r) { return r < MP ? (r & 8191) : 2048 + ((r - MP) & 63); }
DI float lg_gamma(int head) { return head == 0 ? -0.04580368961312479f : head == 1 ? -0.02272007650008353f : head == 2 ? -0.011315313227834146f : -0.005646563141142063f; }
DI float ex2(float x) { return __builtin_amdgcn_exp2f(x); }
DI float siluf(float g) { return g * __builtin_amdgcn_rcpf(1.f + ex2(-g * LOG2E)); }
DI float wave_sum(float v) {
#pragma unroll
    for (int o = 1; o < 64; o <<= 1) v += __shfl_xor(v, o);
    return v;
}
DI bf16x8 pack8(const f32x16& x, int s) {
    u32x4 p; p.x = pk2(x[8 * s], x[8 * s + 1]); p.y = pk2(x[8 * s + 2], x[8 * s + 3]); p.z = pk2(x[8 * s + 4], x[8 * s + 5]); p.w = pk2(x[8 * s + 6], x[8 * s + 7]);
    return __builtin_bit_cast(bf16x8, p);
}
DI bf16x8 ld8(const bf16_t* p) { return *(const bf16x8*)p; }
DI bf16x8 ld44(const bf16_t* p, int stride = 8) {
    const s16x4 lo = *(const s16x4*)p, hi = *(const s16x4*)(p + stride);
    return __builtin_shufflevector(lo, hi, 0, 1, 2, 3, 4, 5, 6, 7);
}

DI u32x4 tr8x8(u32x4 w, int lane) {
    { const bool b = (lane & 4) != 0;
      const unsigned s0 = b ? w.x : w.z, s1 = b ? w.y : w.w, r0 = __shfl_xor(s0, 4), r1 = __shfl_xor(s1, 4);
      if (b) { w.x = r0; w.y = r1; } else { w.z = r0; w.w = r1; } }
    { const bool b = (lane & 2) != 0;
      const unsigned s0 = b ? w.x : w.y, s1 = b ? w.z : w.w, r0 = __shfl_xor(s0, 2), r1 = __shfl_xor(s1, 2);
      if (b) { w.x = r0; w.z = r1; } else { w.y = r0; w.w = r1; } }
    { const bool b = (lane & 1) != 0;
      const unsigned p0 = __shfl_xor(w.x, 1), p1 = __shfl_xor(w.y, 1), p2 = __shfl_xor(w.z, 1), p3 = __shfl_xor(w.w, 1);
      if (b) { w.x = (p0 >> 16) | (w.x & 0xffff0000u); w.y = (p1 >> 16) | (w.y & 0xffff0000u); w.z = (p2 >> 16) | (w.z & 0xffff0000u); w.w = (p3 >> 16) | (w.w & 0xffff0000u); }
      else   { w.x = (w.x & 0xffffu) | (p0 << 16); w.y = (w.y & 0xffffu) | (p1 << 16); w.z = (w.z & 0xffffu) | (p2 << 16); w.w = (w.w & 0xffffu) | (p3 << 16); } }
    return w;
}

struct EpiSwiGLU {
    static constexpr bool PERM = true, AFTER_DRAIN = false;
    bf16_t* O;
    DI void operator()(const f32x4 (&acc)[2][2][4][2], const Unit& u, int wr, int wc, int fr, int fq) const {
        asm volatile("" : "+v"(fr), "+v"(fq));
        const int rl0 = wr * 64 + fr, kt = 2 * u.pn + (wc >> 1), cin = 32 * (wc & 1) + 8 * fq;
        bf16_t* blk = O + ((size_t)(u.pm * (FF / 64) + kt) * 256) * 64 + cin;
#pragma unroll
        for (int ai = 0; ai < 2; ++ai)
#pragma unroll
            for (int m = 0; m < 4; ++m) {
                const f32x4 g0 = acc[ai][0][m][0], g1 = acc[ai][0][m][1], u0 = acc[ai][1][m][0], u1 = acc[ai][1][m][1];
                u32x4 w;
                w.x = pk2(siluf(g0[0]) * u0[0], siluf(g0[1]) * u0[1]); w.y = pk2(siluf(g0[2]) * u0[2], siluf(g0[3]) * u0[3]);
                w.z = pk2(siluf(g1[0]) * u1[0], siluf(g1[1]) * u1[1]); w.w = pk2(siluf(g1[2]) * u1[2], siluf(g1[3]) * u1[3]);
                *(u32x4*)(blk + (size_t)(rl0 + ai * 128 + m * 16) * 64) = w;
            }
    }
};
struct EpiResid {
    static constexpr bool PERM = true, AFTER_DRAIN = false;
    const float* baseP; const float* baseS; float* out; const float* mod; int gofs; float gscale; int mode;
    DI void operator()(const f32x4 (&acc)[2][2][4][2], const Unit& u, int wr, int wc, int fr, int fq) const {
        asm volatile("" : "+v"(fr), "+v"(fq));
        const int row0 = u.pm * 256 + wr * 64 + fr, col0 = u.pn * 256 + wc * 32 + 8 * fq;
        bf16_t* xb = (bf16_t*)((unsigned char*)const_cast<float*>(mod) + (WS_XB - WS_MOD));
#pragma unroll
        for (int ai = 0; ai < 2; ++ai) {
            const float* mb = mod + (size_t)row_batch(u.pm * 256 + ai * 128 + wr * 64) * NMOD + gofs;
            f32x4 gv[2][2];
#pragma unroll
            for (int bj = 0; bj < 2; ++bj)
#pragma unroll
                for (int n = 0; n < 2; ++n) gv[bj][n] = *(const f32x4*)(mb + col0 + bj * 128 + n * 4) * gscale;
#pragma unroll
            for (int m = 0; m < 4; ++m) {
                const int row = row0 + ai * 128 + m * 16;
                f32x4 bv[2][2];
                if (mode == 0) {
                    const float* bp = row < MP ? baseP + (size_t)row * D : baseS + (size_t)(row - MP) * D;
#pragma unroll
                    for (int bj = 0; bj < 2; ++bj)
#pragma unroll
                        for (int n = 0; n < 2; ++n) bv[bj][n] = *(const f32x4*)(bp + col0 + bj * 128 + n * 4);
                } else {
#pragma unroll
                    for (int bj = 0; bj < 2; ++bj) { const u32x4 w = *(const u32x4*)(xb + (size_t)row * D + col0 + bj * 128);
                        u32x2 t; t.x = w.x; t.y = w.y; bv[bj][0] = bf4(t); t.x = w.z; t.y = w.w; bv[bj][1] = bf4(t); }
                }
#pragma unroll
                for (int bj = 0; bj < 2; ++bj) {
                    const f32x4 o0 = bv[bj][0] + gv[bj][0] * acc[ai][bj][m][0], o1 = bv[bj][1] + gv[bj][1] * acc[ai][bj][m][1];
                    if (mode == 2) { float* op = out + (size_t)row * D + col0 + bj * 128; *(f32x4*)op = o0; *(f32x4*)(op + 4) = o1; }
                    else { u32x4 w; w.x = pk2(o0[0], o0[1]); w.y = pk2(o0[2], o0[3]); w.z = pk2(o1[0], o1[1]); w.w = pk2(o1[2], o1[3]); *(u32x4*)(xb + (size_t)row * D + col0 + bj * 128) = w; }
                }
            }
        }
    }
};
struct EpiIn {
    static constexpr bool PERM = true, AFTER_DRAIN = false;
    const float* gq; const float* gk; const f32x2* tab;
    float* outf;
    unsigned char* ws;
    DI void operator()(const f32x4 (&acc)[2][2][4][2], const Unit& u, int wr, int wc, int fr, int fq) const {
        asm volatile("" : "+v"(fr), "+v"(fq));
        const int pn = u.pn, rbase = u.pm * 256 + wr * 64 + fr, e0 = 8 * fq;
        if (pn < 4) {
            const bool isk = pn >= 2; const int head = 4 * (pn & 1) + wc;
            const float* gain = isk ? gk : gq;
            f32x4 gv[2][2];
#pragma unroll
            for (int bj = 0; bj < 2; ++bj)
#pragma unroll
                for (int n = 0; n < 2; ++n) gv[bj][n] = *(const f32x4*)(gain + 32 * bj + e0 + 4 * n);
            bf16_t* ob = (bf16_t*)(ws + (isk ? WS_SBK : WS_SBQ));
#pragma unroll
            for (int ai = 0; ai < 2; ++ai)
#pragma unroll
                for (int m = 0; m < 4; ++m) {
                    const int row = rbase + ai * 128 + m * 16;
                    float ss = 0.f;
#pragma unroll
                    for (int bj = 0; bj < 2; ++bj)
#pragma unroll
                        for (int n = 0; n < 2; ++n) { const f32x4 x = acc[ai][bj][m][n]; ss += (x[0] * x[0] + x[1] * x[1]) + (x[2] * x[2] + x[3] * x[3]); }
                    ss += __shfl_xor(ss, 16); ss += __shfl_xor(ss, 32);
                    float inv = __builtin_amdgcn_rsqf(ss * (1.f / 64.f) + EPS);
                    const float invq = isk ? inv : inv * QSCALE;
#pragma unroll
                    for (int bj = 0; bj < 2; ++bj) {
                        const f32x4 v0 = acc[ai][bj][m][0] * gv[bj][0], v1 = acc[ai][bj][m][1] * gv[bj][1];
                        const f32x4 w0 = v0 * invq, w1 = v1 * invq;
                        u32x4 w; w.x = pk2(w0[0], w0[1]); w.y = pk2(w0[2], w0[3]); w.z = pk2(w1[0], w1[1]); w.w = pk2(w1[2], w1[3]);
                        *(u32x4*)(ob + (size_t)row * 512 + head * 64 + 32 * bj + e0) = w;
                        if (isk) {
                            float* o = (row < MP ? outf + O_KP + (size_t)row * 512 : outf + O_KS + (size_t)(row - MP) * 512) + head * 64 + 32 * bj + e0;
                            *(f32x4*)o = w0; *(f32x4*)(o + 4) = w1;
                        }
                    }
                }
        } else if (pn < 6) {
            const int head = 4 * (pn - 4) + wc;
            bf16_t* vt = (bf16_t*)(ws + WS_SBVT);
#pragma unroll
            for (int ai = 0; ai < 2; ++ai)
#pragma unroll
                for (int m = 0; m < 4; ++m) {
                    const int row = rbase + ai * 128 + m * 16;
                    float* o = (row < MP ? outf + O_VP + (size_t)row * 512 : outf + O_VS + (size_t)(row - MP) * 512) + head * 64 + e0;
                    bf16_t* t = vt + (((size_t)((row >> 5) * 8 + head) * 4 + ((row >> 3) & 3)) * 64 + e0 + (fr & 7)) * 8;
#pragma unroll
                    for (int bj = 0; bj < 2; ++bj) {
                        const f32x4 x0 = acc[ai][bj][m][0], x1 = acc[ai][bj][m][1];
                        *(f32x4*)(o + 32 * bj) = x0; *(f32x4*)(o + 32 * bj + 4) = x1;
                        u32x4 w; w.x = pk2(x0[0], x0[1]); w.y = pk2(x0[2], x0[3]); w.z = pk2(x1[0], x1[1]); w.w = pk2(x1[2], x1[3]);
                        *(u32x4*)(t + 32 * bj * 8) = tr8x8(w, fr);
                    }
                }
        } else {
            const int q = pn - 6, kind = q >> 1, head = 2 * (q & 1) + (wc >> 1), f0 = 32 * (wc & 1) + e0;
            const float lg = lg_gamma(head);
            if (kind <= 1) {
                bf16_t* ob = (bf16_t*)(ws + (kind ? WS_RK : WS_RQ));
                bf16_t* kt = (bf16_t*)(ws + WS_RKT);
#pragma unroll
                for (int ai = 0; ai < 2; ++ai)
#pragma unroll
                    for (int m = 0; m < 4; ++m) {
                        asm volatile("" ::: "memory");
                        const int row = rbase + ai * 128 + m * 16, pos = row_pos(row), ic = pos & 63;
                        const float sc = kind ? KSCALE * ex2(-(float)ic * lg) : ex2((float)ic * lg);
                        const f32x4* tp = (const f32x4*)(tab + (size_t)pos * 64 + f0);
                        f32x4 o1[2], o2[2];
#pragma unroll
                        for (int n = 0; n < 2; ++n) {
                            const f32x4 t0 = tp[2 * n], t1 = tp[2 * n + 1];
                            const f32x4 x1 = acc[ai][0][m][n], x2 = acc[ai][1][m][n];
                            const f32x4 cc = {t0[0], t0[2], t1[0], t1[2]}, sn = {t0[1], t0[3], t1[1], t1[3]};
                            o1[n] = (x1 * cc - x2 * sn) * sc; o2[n] = (x1 * sn + x2 * cc) * sc;
                        }
                        u32x4 w1, w2;
                        w1.x = pk2(o1[0][0], o1[0][1]); w1.y = pk2(o1[0][2], o1[0][3]); w1.z = pk2(o1[1][0], o1[1][1]); w1.w = pk2(o1[1][2], o1[1][3]);
                        w2.x = pk2(o2[0][0], o2[0][1]); w2.y = pk2(o2[0][2], o2[0][3]); w2.z = pk2(o2[1][0], o2[1][1]); w2.w = pk2(o2[1][2], o2[1][3]);
                        bf16_t* p = ob + (size_t)row * 512 + head * 128 + f0;
                        *(u32x4*)p = w1; *(u32x4*)(p + 64) = w2;
                        asm volatile("" ::: "memory");
                        if (kind) {
                            bf16_t* t = kt + (((size_t)((row >> 6) * 4 + head) * 8 + ((row >> 3) & 7)) * 128 + f0 + (fr & 7)) * 8;
                            *(u32x4*)t = tr8x8(w1, fr); *(u32x4*)(t + 64 * 8) = tr8x8(w2, fr);
                        }
                    }
            } else if (kind == 2) {
                bf16_t* vt = (bf16_t*)(ws + WS_RVT);
#pragma unroll
                for (int ai = 0; ai < 2; ++ai)
#pragma unroll
                    for (int m = 0; m < 4; ++m) {
                        const int row = rbase + ai * 128 + m * 16;
                        bf16_t* t = vt + (((size_t)((row >> 6) * 4 + head) * 8 + ((row >> 3) & 7)) * 128 + f0 + (fr & 7)) * 8;
#pragma unroll
                        for (int bj = 0; bj < 2; ++bj) {
                            const f32x4 x0 = acc[ai][bj][m][0], x1 = acc[ai][bj][m][1];
                            u32x4 w; w.x = pk2(x0[0], x0[1]); w.y = pk2(x0[2], x0[3]); w.z = pk2(x1[0], x1[1]); w.w = pk2(x1[2], x1[3]);
                            *(u32x4*)(t + 64 * bj * 8) = tr8x8(w, fr);
                        }
                    }
            } else {
                bf16_t* ob = (bf16_t*)(ws + WS_RG);
#pragma unroll
                for (int ai = 0; ai < 2; ++ai)
#pragma unroll
                    for (int m = 0; m < 4; ++m) {
                        const int row = rbase + ai * 128 + m * 16;
#pragma unroll
                        for (int bj = 0; bj < 2; ++bj) {
                            const f32x4 x0 = acc[ai][bj][m][0], x1 = acc[ai][bj][m][1];
                            u32x4 w; w.x = pk2(siluf(x0[0]), siluf(x0[1])); w.y = pk2(siluf(x0[2]), siluf(x0[3])); w.z = pk2(siluf(x1[0]), siluf(x1[1])); w.w = pk2(siluf(x1[2]), siluf(x1[3]));
                            *(u32x4*)(ob + (size_t)row * 512 + head * 128 + 64 * bj + f0) = w;
                        }
                    }
            }
        }
    }
};

DI int srccol_in(int cp) {
    const int pn = cp >> 8, loc = cp & 255, bj = loc >> 7, wc = (loc & 127) >> 5;
    if (pn < 6) { const int seg = pn >> 1, pp = pn & 1; return seg * 512 + 64 * (4 * pp + wc) + 32 * bj; }
    const int q = pn - 6, seg = q >> 1, pp = q & 1; return 1536 + seg * 512 + 128 * (2 * pp + (wc >> 1)) + 64 * bj + 32 * (wc & 1);
}
DI int srccol_up(int cp) { const int pn = cp >> 8, bj = (cp >> 7) & 1, i = cp & 127; return bj * FF + 128 * pn + i; }

DI void p0_transpose_item(const float* W, int K, int N, int srcc, bf16_t* WT, int dstr, int k0, LAS float* scr, int lane) {
#pragma unroll 8
    for (int i = 0; i < 32; ++i) { const int kk = 2 * i + (lane >> 5); scr[kk * 33 + (lane & 31)] = W[(size_t)(k0 + kk) * N + srcc + (lane & 31)]; }
    asm volatile("s_waitcnt lgkmcnt(0)" ::: "memory");
    const int c = lane & 7;
#pragma unroll
    for (int j = 0; j < 4; ++j) { const int n = (lane >> 3) + 8 * j; const LAS float* s = scr + (8 * c) * 33 + n;
        u32x4 o; o.x = pk2(s[0 * 33], s[1 * 33]); o.y = pk2(s[2 * 33], s[3 * 33]); o.z = pk2(s[4 * 33], s[5 * 33]); o.w = pk2(s[6 * 33], s[7 * 33]);
        *(u32x4*)(WT + (size_t)(dstr + n) * K + k0 + 8 * c) = o; }
    asm volatile("s_waitcnt lgkmcnt(0)" ::: "memory");
}
DI void ada_item(int it, const float* cP, const float* cS, const float* wada, const float* bada, float* mod, LAS float* red, int tid, int wave, int lane) {
    const int c0 = it * 64;
    LAS float* cs = red + wave * (64 * 36);
    float acc[36];
#pragma unroll
    for (int b = 0; b < 36; ++b) acc[b] = 0.f;
#pragma unroll 1
    for (int u = 0; u < 2; ++u) {
        const int kb = 128 * wave + 64 * u;
#pragma unroll 4
        for (int b = 0; b < 36; ++b) { const float cv = b < 4 ? cP[b * 1024 + kb + lane] : cS[(b - 4) * 1024 + kb + lane]; cs[lane * 36 + b] = cv / (1.f + __expf(-cv)); }
        asm volatile("s_waitcnt lgkmcnt(0)" ::: "memory");
#pragma unroll 1
        for (int k8 = 0; k8 < 8; ++k8) {
            float wv[8];
#pragma unroll
            for (int j = 0; j < 8; ++j) wv[j] = wada[(size_t)(kb + 8 * k8 + j) * NMOD + c0 + lane];
#pragma unroll
            for (int j = 0; j < 8; ++j) {
                const LAS f32x4* cr = (const LAS f32x4*)(cs + (8 * k8 + j) * 36);
#pragma unroll
                for (int q = 0; q < 9; ++q) { const f32x4 c4 = cr[q]; acc[4 * q] += c4[0] * wv[j]; acc[4 * q + 1] += c4[1] * wv[j]; acc[4 * q + 2] += c4[2] * wv[j]; acc[4 * q + 3] += c4[3] * wv[j]; }
            }
        }
        asm volatile("s_waitcnt lgkmcnt(0)" ::: "memory");
    }
    __syncthreads();
#pragma unroll
    for (int b = 0; b < 36; ++b) red[(wave * 36 + b) * 64 + lane] = acc[b];
    __syncthreads();
    for (int o = tid; o < 36 * 64; o += 512) {
        const int b = o >> 6, l = o & 63; float s = 0.f;
#pragma unroll
        for (int w = 0; w < 8; ++w) s += red[(w * 36 + b) * 64 + l];
        mod[(size_t)b * NMOD + c0 + l] = s + bada[c0 + l];
    }
    __syncthreads();
}

struct Args {
    const float* in[20]; float* out; unsigned char* ws;
};

DI void p0_prologue(const Args& a, LAS unsigned char* lds, int tid, int wave, int lane, bool first) {
    unsigned char* ws = a.ws;
    if (blockIdx.x == 0 && first) { for (int i = tid; i < 8192; i += 512) ((unsigned*)(ws + WS_CTL))[i] = 0u; for (int i = tid; i < 4096; i += 512) ((unsigned*)(ws + WS_BAR))[i] = 0u; }
    for (int it = blockIdx.x; it < NMOD / 64; it += gridDim.x)
        ada_item(it, a.in[5], a.in[6], a.in[7], a.in[8], (float*)(ws + WS_MOD), (LAS float*)lds, tid, wave, lane);
    for (int idx = blockIdx.x * 512 + tid; idx < 8192 * 64; idx += gridDim.x * 512) {
        const int pos = idx >> 6, f = idx & 63;
        const double xd = -(double)f * 0.20762050593046014; const double nf = __builtin_floor(xd);
        const float fr = (float)(xd - nf);
        const float ifr = __builtin_ldexpf(ex2(fr), (int)nf);
        const double rev = (double)pos * (double)ifr * 0.15915494309189535; const float frac = (float)(rev - __builtin_floor(rev));
        f32x2 cs; cs.x = __builtin_amdgcn_cosf(frac); cs.y = __builtin_amdgcn_sinf(frac);
        ((f32x2*)(ws + WS_ROPE))[idx] = cs;
    }
    LAS float* scr = (LAS float*)(lds + wave * 16384);
    const int gw = blockIdx.x * 8 + wave, NGW = gridDim.x * 8;
    constexpr int I_UP = (D / 64) * (NUP / 32), I_DN = (FF / 64) * (D / 32), I_IN = (D / 64) * (NIN / 32), I_OUT = (D / 64) * (D / 32);
    constexpr int NITEMS = 2 * I_UP + 2 * I_DN + I_IN + I_OUT;
    for (int it = gw; it < NITEMS; it += NGW) {
        int r = it;
        if (r < 2 * I_UP) { const int which = r >= I_UP; r -= which * I_UP; const int nb = r % (NUP / 32), kb = r / (NUP / 32);
            p0_transpose_item(a.in[which ? 18 : 12], D, NUP, srccol_up(32 * nb), (bf16_t*)(ws + (which ? WS_WUP2 : WS_WUP1)), 32 * nb, 64 * kb, scr, lane); continue; }
        r -= 2 * I_UP;
        if (r < 2 * I_DN) { const int which = r >= I_DN; r -= which * I_DN; const int nb = r % (D / 32), kb = r / (D / 32);
            p0_transpose_item(a.in[which ? 19 : 13], FF, D, 32 * nb, (bf16_t*)(ws + (which ? WS_WDN2 : WS_WDN1)), 32 * nb, 64 * kb, scr, lane); continue; }
        r -= 2 * I_DN;
        if (r < I_IN) { const int nb = r % (NIN / 32), kb = r / (NIN / 32);
            p0_transpose_item(a.in[14], D, NIN, srccol_in(32 * nb), (bf16_t*)(ws + WS_WIN), 32 * nb, 64 * kb, scr, lane); continue; }
        r -= I_IN;
        { const int nb = r % (D / 32), kb = r / (D / 32);
            p0_transpose_item(a.in[17], D, D, 32 * nb, (bf16_t*)(ws + WS_WOUT), 32 * nb, 64 * kb, scr, lane); }
    }
}

DI void norm_finish(int m, const f32x4 (&v)[4], float s, const float* gain, const float* mod, int shofs, int scofs, bf16_t* XN, int lane) {
    const float* mb = mod + (size_t)row_batch(m) * NMOD;
    const float inv = __builtin_amdgcn_rsqf(s * (1.f / D) + EPS);
    u32x2* o8 = (u32x2*)(XN + (size_t)m * D) + lane;
#pragma unroll
    for (int j = 0; j < 4; ++j) {
        const int c = 4 * (64 * j + lane);
        const f32x4 g4 = *(const f32x4*)(gain + c), sc4 = *(const f32x4*)(mb + scofs + c), sh4 = *(const f32x4*)(mb + shofs + c);
        const f32x4 o = v[j] * inv * g4 * (sc4 + 1.f) + sh4;
        u32x2 w; w.x = pk2(o[0], o[1]); w.y = pk2(o[2], o[3]); o8[64 * j] = w;
    }
}
DI void norm_phase(const float* srcP, const float* srcS, const bf16_t* srcB, const float* gain, const float* mod, int shofs, int scofs, bf16_t* XN, int wave, int lane) {
    const int gw = blockIdx.x * 8 + wave, NGW = gridDim.x * 8;
    for (int m = gw; m < M; m += 2 * NGW) {
        const int m2 = m + NGW; const bool two = m2 < M; const int mb2 = two ? m2 : m;
        const f32x4* xa = (const f32x4*)(m < MP ? srcP + (size_t)m * D : srcS + (size_t)(m - MP) * D) + lane;
        const f32x4* xb = (const f32x4*)(mb2 < MP ? srcP + (size_t)mb2 * D : srcS + (size_t)(mb2 - MP) * D) + lane;
        f32x4 va[4], vb[4]; float sa = 0.f, sb = 0.f;
        if (srcB) {
            const u32x2* ba = (const u32x2*)(srcB + (size_t)m * D) + lane; const u32x2* bb = (const u32x2*)(srcB + (size_t)mb2 * D) + lane;
#pragma unroll
            for (int j = 0; j < 4; ++j) { va[j] = bf4(ba[64 * j]); vb[j] = bf4(bb[64 * j]); }
        } else {
#pragma unroll
            for (int j = 0; j < 4; ++j) { va[j] = xa[64 * j]; vb[j] = xb[64 * j]; }
        }
#pragma unroll
        for (int j = 0; j < 4; ++j) { sa += (va[j][0] * va[j][0] + va[j][1] * va[j][1]) + (va[j][2] * va[j][2] + va[j][3] * va[j][3]); sb += (vb[j][0] * vb[j][0] + vb[j][1] * vb[j][1]) + (vb[j][2] * vb[j][2] + vb[j][3] * vb[j][3]); }
#pragma unroll
        for (int o = 1; o < 64; o <<= 1) { sa += __shfl_xor(sa, o); sb += __shfl_xor(sb, o); }
        norm_finish(m, va, sa, gain, mod, shofs, scofs, XN, lane);
        if (two) norm_finish(m2, vb, sb, gain, mod, shofs, scofs, XN, lane);
    }
}

DI void norm_row16_finish(int m, const f32x4 (&v)[4], float s, const float* gain, const float* mod, int shofs, int scofs, bf16_t* XN, int lane) {
    const float* mb = mod + (size_t)row_batch(m) * NMOD;
    const float inv = __builtin_amdgcn_rsqf(s * (1.f / D) + EPS);
#pragma unroll
    for (int j = 0; j < 2; ++j) {
        const int c = 8 * (64 * j + lane);
        u32x4 w;
#pragma unroll
        for (int q = 0; q < 2; ++q) {
            const f32x4 g4 = *(const f32x4*)(gain + c + 4 * q), sc4 = *(const f32x4*)(mb + scofs + c + 4 * q), sh4 = *(const f32x4*)(mb + shofs + c + 4 * q);
            const f32x4 o = v[2 * j + q] * inv * g4 * (sc4 + 1.f) + sh4;
            if (q == 0) { w.x = pk2(o[0], o[1]); w.y = pk2(o[2], o[3]); } else { w.z = pk2(o[0], o[1]); w.w = pk2(o[2], o[3]); }
        }
        *(u32x4*)(XN + (size_t)m * D + c) = w;
    }
}
DI void norm_phase_b16(const bf16_t* src, const float* gain, const float* mod, int shofs, int scofs, bf16_t* XN, int wave, int lane) {
    const int gw = blockIdx.x * 8 + wave, NGW = gridDim.x * 8;
    for (int m = gw; m < M; m += 2 * NGW) {
        const int m2 = m + NGW; const bool two = m2 < M; const int mb2 = two ? m2 : m;
        f32x4 va[4], vb[4]; float sa = 0.f, sb = 0.f;
#pragma unroll
        for (int j = 0; j < 2; ++j) {
            const u32x4 a = *(const u32x4*)(src + (size_t)m * D + 8 * (64 * j + lane)), b = *(const u32x4*)(src + (size_t)mb2 * D + 8 * (64 * j + lane));
            u32x2 t; t.x = a.x; t.y = a.y; va[2 * j] = bf4(t); t.x = a.z; t.y = a.w; va[2 * j + 1] = bf4(t);
            t.x = b.x; t.y = b.y; vb[2 * j] = bf4(t); t.x = b.z; t.y = b.w; vb[2 * j + 1] = bf4(t);
        }
#pragma unroll
        for (int j = 0; j < 4; ++j) { sa += (va[j][0] * va[j][0] + va[j][1] * va[j][1]) + (va[j][2] * va[j][2] + va[j][3] * va[j][3]); sb += (vb[j][0] * vb[j][0] + vb[j][1] * vb[j][1]) + (vb[j][2] * vb[j][2] + vb[j][3] * vb[j][3]); }
#pragma unroll
        for (int o = 1; o < 64; o <<= 1) { sa += __shfl_xor(sa, o); sb += __shfl_xor(sb, o); }
        norm_row16_finish(m, va, sa, gain, mod, shofs, scofs, XN, lane);
        if (two) norm_row16_finish(m2, vb, sb, gain, mod, shofs, scofs, XN, lane);
    }
}

DI void sb_tile(f32x16& O0, f32x16& O1, float& carry, const bf16x8 (&qf)[4], const bf16x8 (&kf)[4], const bf16x8 (&vf)[2][2], bool diag, int lane) {
    f32x16 S;
#pragma unroll
    for (int i = 0; i < 16; ++i) S[i] = 0.f;
#pragma unroll
    for (int ks = 0; ks < 4; ++ks) S = MFMA32(kf[ks], qf[ks], S);
    const int h = lane >> 5, qn = lane & 31;
    float beta[16], ein[16], G[4];
#pragma unroll
    for (int g = 0; g < 4; ++g) {
        float av[4];
#pragma unroll
        for (int r = 0; r < 4; ++r) {
            const int i = 4 * g + r;
            const float z = __builtin_fmaxf(S[i], -100.f);
            const float t = ex2(-z);
            float b = __builtin_amdgcn_rcpf(1.f + t), a = t * b;
            if (diag) { const bool ok = (8 * g + 4 * h + r) < qn; b = ok ? b : 0.f; a = ok ? a : 1.f; }
            beta[i] = b; av[r] = a;
        }
        ein[4 * g + 3] = 1.f; ein[4 * g + 2] = av[3]; ein[4 * g + 1] = av[3] * av[2]; ein[4 * g] = ein[4 * g + 1] * av[1]; G[g] = ein[4 * g] * av[0];
    }
    float Go[4], PP[4], later[4];
#pragma unroll
    for (int g = 0; g < 4; ++g) { Go[g] = __shfl_xor(G[g], 32); PP[g] = G[g] * Go[g]; }
    later[3] = carry; later[2] = later[3] * PP[3]; later[1] = later[2] * PP[2]; later[0] = later[1] * PP[1];
    carry = later[0] * PP[0];
    f32x16 W;
#pragma unroll
    for (int g = 0; g < 4; ++g) {
        const float lt = later[g] * (h == 0 ? Go[g] : 1.f);
#pragma unroll
        for (int r = 0; r < 4; ++r) W[4 * g + r] = beta[4 * g + r] * ein[4 * g + r] * lt;
    }
#pragma unroll
    for (int s = 0; s < 2; ++s) { const bf16x8 wb = pack8(W, s); O0 = MFMA32(vf[0][s], wb, O0); O1 = MFMA32(vf[1][s], wb, O1); }
}
DI void sb_item(int item, const Args& a, int lane) {
    unsigned char* ws = a.ws;
    const bf16_t* SBQ = (const bf16_t*)(ws + WS_SBQ); const bf16_t* SBK = (const bf16_t*)(ws + WS_SBK); const bf16_t* SBVT = (const bf16_t*)(ws + WS_SBVT);
    bf16_t* MIX = (bf16_t*)(ws + WS_MIX);
    const int head = item & 7, gt = item >> 3, row0 = gt * 32, h = lane >> 5, ln = lane & 31;
    bf16x8 qf[4];
#pragma unroll
    for (int ks = 0; ks < 4; ++ks) qf[ks] = ld8(SBQ + (size_t)(row0 + ln) * 512 + head * 64 + 16 * ks + 8 * h);
    f32x16 O0, O1;
#pragma unroll
    for (int i = 0; i < 16; ++i) { O0[i] = 0.f; O1[i] = 0.f; }
    float carry = 1.f;
    const bool prompt = row0 < MP;
    const int gt_last = prompt ? (gt & ~255) : (gt & ~1);
    bool done = false;
    {
        bf16x8 kf[4], vf[2][2];
#pragma unroll
        for (int ks = 0; ks < 4; ++ks) kf[ks] = ld8(SBK + (size_t)(gt * 32 + ln) * 512 + head * 64 + 16 * ks + 8 * h);
#pragma unroll
        for (int ds = 0; ds < 2; ++ds)
#pragma unroll
            for (int s = 0; s < 2; ++s) vf[ds][s] = ld44(SBVT + (((size_t)(gt * 8 + head) * 4 + 2 * s) * 64 + 32 * ds + ln) * 8 + 4 * h, 512);
        for (int kt = gt;; --kt) {
            const bool more = kt > gt_last;
            bf16x8 kn[4], vn[2][2];
            const int kp = more ? kt - 1 : kt;
#pragma unroll
            for (int ks = 0; ks < 4; ++ks) kn[ks] = ld8(SBK + (size_t)(kp * 32 + ln) * 512 + head * 64 + 16 * ks + 8 * h);
#pragma unroll
            for (int ds = 0; ds < 2; ++ds)
#pragma unroll
                for (int s = 0; s < 2; ++s) vn[ds][s] = ld44(SBVT + (((size_t)(kp * 8 + head) * 4 + 2 * s) * 64 + 32 * ds + ln) * 8 + 4 * h, 512);
            __builtin_amdgcn_sched_barrier(0);
            sb_tile(O0, O1, carry, qf, kf, vf, kt == gt, lane);
            asm volatile("" :: "v"(kn[0]), "v"(kn[1]), "v"(kn[2]), "v"(kn[3]), "v"(vn[0][0]), "v"(vn[0][1]), "v"(vn[1][0]), "v"(vn[1][1]));
            if (__all(carry < SB_EXIT)) { done = true; break; }
            if (!more) break;
#pragma unroll
            for (int ks = 0; ks < 4; ++ks) kf[ks] = kn[ks];
#pragma unroll
            for (int ds = 0; ds < 2; ++ds)
#pragma unroll
                for (int s = 0; s < 2; ++s) vf[ds][s] = vn[ds][s];
        }
    }
    if (!prompt && !done) {
        const int bs = (row0 - MP) >> 6;
        const float* ck = a.in[2] + (size_t)bs * 2048 * 512 + head * 64;
        const float* cv = a.in[3] + (size_t)bs * 2048 * 512 + head * 64;
        for (int t0 = 2048 - 32; t0 >= 0; t0 -= 32) {
            bf16x8 kf[4], vf[2][2];
#pragma unroll
            for (int ks = 0; ks < 4; ++ks) {
                const f32x4* p = (const f32x4*)(ck + (size_t)(t0 + ln) * 512 + 16 * ks + 8 * h);
                const f32x4 x0 = p[0], x1 = p[1];
                u32x4 w; w.x = pk2(x0[0], x0[1]); w.y = pk2(x0[2], x0[3]); w.z = pk2(x1[0], x1[1]); w.w = pk2(x1[2], x1[3]);
                kf[ks] = __builtin_bit_cast(bf16x8, w);
            }
#pragma unroll
            for (int ds = 0; ds < 2; ++ds)
#pragma unroll
                for (int s = 0; s < 2; ++s) {
                    float x[8];
#pragma unroll
                    for (int j = 0; j < 8; ++j) x[j] = cv[(size_t)(t0 + 16 * s + 8 * (j >> 2) + 4 * h + (j & 3)) * 512 + 32 * ds + ln];
                    u32x4 w; w.x = pk2(x[0], x[1]); w.y = pk2(x[2], x[3]); w.z = pk2(x[4], x[5]); w.w = pk2(x[6], x[7]);
                    vf[ds][s] = __builtin_bit_cast(bf16x8, w);
                }
            sb_tile(O0, O1, carry, qf, kf, vf, false, lane);
            if (__all(carry < SB_EXIT)) break;
        }
    }
    bf16_t* op = MIX + (size_t)(row0 + ln) * D + head * 64 + 4 * h;
#pragma unroll
    for (int g = 0; g < 4; ++g) {
        u32x2 w0, w1; w0.x = pk2(O0[4 * g], O0[4 * g + 1]); w0.y = pk2(O0[4 * g + 2], O0[4 * g + 3]); w1.x = pk2(O1[4 * g], O1[4 * g + 1]); w1.y = pk2(O1[4 * g + 2], O1[4 * g + 3]);
        *(u32x2*)(op + 8 * g) = w0; *(u32x2*)(op + 32 + 8 * g) = w1;
    }
}

DI void ret_update(f32x16 (&T)[4], const bf16_t* kt, const bf16_t* vt, float c, int slice, int lane) {
    const int h = lane >> 5, ln = lane & 31;
    bf16x8 vfr[4];
#pragma unroll
    for (int ks = 0; ks < 4; ++ks) vfr[ks] = ld8(vt + ((size_t)(2 * ks + h) * 128 + 32 * slice + ln) * 8);
#pragma unroll
    for (int ms = 0; ms < 4; ++ms) {
        T[ms] = T[ms] * c;
#pragma unroll
        for (int ks = 0; ks < 4; ++ks) T[ms] = MFMA32(ld8(kt + ((size_t)(2 * ks + h) * 128 + 32 * ms + ln) * 8), vfr[ks], T[ms]);
    }
}
DI void ret_loadA(bf16x8 (&kfr)[4][4], bf16x8 (&vfr)[4], const bf16_t* kt, const bf16_t* vt, int slice, int lane) {
    const int h = lane >> 5, ln = lane & 31;
#pragma unroll
    for (int ks = 0; ks < 4; ++ks) vfr[ks] = ld8(vt + ((size_t)(2 * ks + h) * 128 + 32 * slice + ln) * 8);
#pragma unroll
    for (int ms = 0; ms < 4; ++ms)
#pragma unroll
        for (int ks = 0; ks < 4; ++ks) kfr[ms][ks] = ld8(kt + ((size_t)(2 * ks + h) * 128 + 32 * ms + ln) * 8);
}
DI void ret_passA(int item, unsigned char* ws, int lane) {
    const int slice = item & 3, g = (item >> 2) % (NG - 1), bh = item / (4 * (NG - 1)), b = bh >> 2, head = bh & 3;
    const float c = ex2(64.f * lg_gamma(head));
    f32x16 T[4];
#pragma unroll
    for (int ms = 0; ms < 4; ++ms)
#pragma unroll
        for (int i = 0; i < 16; ++i) T[ms][i] = 0.f;
    const size_t cg0 = (size_t)(b * 128 + g * CG);
    const bf16_t* KT = (const bf16_t*)(ws + WS_RKT); const bf16_t* VT = (const bf16_t*)(ws + WS_RVT);
    bf16x8 kfr[4][4], vfr[4];
    ret_loadA(kfr, vfr, KT + (cg0 * 4 + head) * 8192, VT + (cg0 * 4 + head) * 8192, slice, lane);
    for (int step = 0; step < CG; ++step) {
        bf16x8 kn[4][4], vn[4];
        const size_t cgn = cg0 + (step < CG - 1 ? step + 1 : step);
        ret_loadA(kn, vn, KT + (cgn * 4 + head) * 8192, VT + (cgn * 4 + head) * 8192, slice, lane);
#pragma unroll
        for (int ms = 0; ms < 4; ++ms) {
            T[ms] = T[ms] * c;
#pragma unroll
            for (int ks = 0; ks < 4; ++ks) T[ms] = MFMA32(kfr[ms][ks], vfr[ks], T[ms]);
        }
#pragma unroll
        for (int ks = 0; ks < 4; ++ks) { vfr[ks] = vn[ks];
#pragma unroll
            for (int ms = 0; ms < 4; ++ms) kfr[ms][ks] = kn[ms][ks]; }
    }
    float* o = (float*)(ws + WS_LT) + (size_t)item * 4096;
#pragma unroll
    for (int ms = 0; ms < 4; ++ms)
#pragma unroll
        for (int i = 0; i < 16; ++i) o[(ms * 16 + i) * 64 + lane] = T[ms][i];
}
constexpr int RB_Q = 0, RB_K = 17408, RB_KT = 34816, RB_VT = 51200, RB_BYTES = 67584, RB_ROW = 272, RB_STATS = 2 * RB_BYTES;
DI bf16x8 lds8(const LAS unsigned char* p) { return *(const LAS bf16x8*)p; }
DI bf16x8 lds44(const LAS unsigned char* p, int stride_bytes) {
    const s16x4 lo = *(const LAS s16x4*)p, hi = *(const LAS s16x4*)(p + stride_bytes);
    return __builtin_shufflevector(lo, hi, 0, 1, 2, 3, 4, 5, 6, 7);
}
DI void ret_stage_load(u32x4 (&r)[16], const bf16_t* RQ, const bf16_t* RK, const bf16_t* kt, const bf16_t* vt, int rc, int head, int t) {
#pragma unroll
    for (int i = 0; i < 4; ++i) { const int q = t + 256 * i; r[i] = *(const u32x4*)(RQ + (size_t)(rc + (q >> 4)) * 512 + head * 128 + (q & 15) * 8); }
#pragma unroll
    for (int i = 0; i < 4; ++i) { const int q = t + 256 * i; r[4 + i] = *(const u32x4*)(RK + (size_t)(rc + (q >> 4)) * 512 + head * 128 + (q & 15) * 8); }
#pragma unroll
    for (int i = 0; i < 4; ++i) { const int q = t + 256 * i; r[8 + i] = *(const u32x4*)(kt + (size_t)q * 8); }
#pragma unroll
    for (int i = 0; i < 4; ++i) { const int q = t + 256 * i; r[12 + i] = *(const u32x4*)(vt + (size_t)q * 8); }
}
DI void ret_stage_store(const u32x4 (&r)[16], LAS unsigned char* buf, int t) {
#pragma unroll
    for (int i = 0; i < 4; ++i) { const int q = t + 256 * i; *(LAS u32x4*)(buf + RB_Q + (q >> 4) * RB_ROW + (q & 15) * 16) = r[i]; }
#pragma unroll
    for (int i = 0; i < 4; ++i) { const int q = t + 256 * i; *(LAS u32x4*)(buf + RB_K + (q >> 4) * RB_ROW + (q & 15) * 16) = r[4 + i]; }
#pragma unroll
    for (int i = 0; i < 4; ++i) { const int q = t + 256 * i; *(LAS u32x4*)(buf + RB_KT + q * 16) = r[8 + i]; }
#pragma unroll
    for (int i = 0; i < 4; ++i) { const int q = t + 256 * i; *(LAS u32x4*)(buf + RB_VT + q * 16) = r[12 + i]; }
}
DI void ret_block(int mode, int ci, const Args& a, LAS unsigned char* lds, int tid, int wave, int lane) {
    unsigned char* ws = a.ws;
    const bf16_t* RQ = (const bf16_t*)(ws + WS_RQ); const bf16_t* RK = (const bf16_t*)(ws + WS_RK);
    int head, row0, nsteps;
    if (mode == 0) { const int bh = ci / NG, g = ci % NG, b = bh >> 2; head = bh & 3; row0 = b * 8192 + g * (64 * CG); nsteps = CG; }
    else { const int bs = ci >> 2; head = ci & 3; row0 = MP + 64 * bs; nsteps = 1; }
    if (wave >= 4) {
        const int lt_ = tid - 256;
        {
            u32x4 r[16]; const size_t cgk = (size_t)(row0 >> 6);
            ret_stage_load(r, RQ, RK, (const bf16_t*)(ws + WS_RKT) + (cgk * 4 + head) * 8192, (const bf16_t*)(ws + WS_RVT) + (cgk * 4 + head) * 8192, row0, head, lt_);
            ret_stage_store(r, lds, lt_);
        }
        __syncthreads();
        for (int step = 0; step < nsteps; ++step) {
            const int rc = row0 + 64 * step;
            LAS unsigned char* nxt = lds + ((step + 1) & 1) * RB_BYTES;
            u32x4 r[16];
            const bool more = step + 1 < nsteps;
            if (more) {
                const size_t cgk = (size_t)((rc + 64) >> 6);
                ret_stage_load(r, RQ, RK, (const bf16_t*)(ws + WS_RKT) + (cgk * 4 + head) * 8192, (const bf16_t*)(ws + WS_RVT) + (cgk * 4 + head) * 8192, rc + 64, head, lt_);
            }
            __syncthreads();
            if (more) ret_stage_store(r, nxt, lt_);
            __syncthreads();
        }
        return;
    }
    const int slice = wave & 3, h = lane >> 5, ln = lane & 31;
    const bf16_t* RG = (const bf16_t*)(ws + WS_RG);
    bf16_t* MIX = (bf16_t*)(ws + WS_MIX);
    LAS float* stats = (LAS float*)(lds + RB_STATS);
    float* sout;
    f32x16 T[4];
    if (mode == 0) {
        const int bh = ci / NG, g = ci % NG;
        sout = (g == NG - 1) ? a.out + O_SP + (size_t)bh * 16384 : nullptr;
        const float c16 = ex2((float)(64 * CG) * lg_gamma(head));
#pragma unroll
        for (int ms = 0; ms < 4; ++ms)
#pragma unroll
            for (int i = 0; i < 16; ++i) T[ms][i] = 0.f;
        if (g > 0) {
            const float* lt0 = (const float*)(ws + WS_LT) + (size_t)((bh * (NG - 1)) * 4 + slice) * 4096 + lane;
            f32x16 L[4];
#pragma unroll
            for (int ms = 0; ms < 4; ++ms)
#pragma unroll
                for (int i = 0; i < 16; ++i) L[ms][i] = lt0[(ms * 16 + i) * 64];
            for (int gp = 0; gp < g; ++gp) {
                f32x16 N[4];
                const float* ltn = lt0 + (size_t)((gp + 1 < g ? gp + 1 : gp) * 4) * 4096;
#pragma unroll
                for (int ms = 0; ms < 4; ++ms)
#pragma unroll
                    for (int i = 0; i < 16; ++i) N[ms][i] = ltn[(ms * 16 + i) * 64];
#pragma unroll
                for (int ms = 0; ms < 4; ++ms) { T[ms] = T[ms] * c16 + L[ms]; L[ms] = N[ms]; }
            }
        }
    } else {
        sout = a.out + O_SS + (size_t)ci * 16384;
        const float* s0 = a.in[4] + (size_t)ci * 16384;
        const float ig = ex2(-63.f * lg_gamma(head));
#pragma unroll
        for (int ms = 0; ms < 4; ++ms)
#pragma unroll
            for (int i = 0; i < 16; ++i) T[ms][i] = s0[(32 * ms + 8 * (i >> 2) + 4 * h + (i & 3)) * 128 + 32 * slice + ln] * ig;
    }
    const float c = ex2(64.f * lg_gamma(head));
    __syncthreads();
    for (int step = 0; step < nsteps; ++step) {
        const int rc = row0 + 64 * step;
        const LAS unsigned char* cur = lds + (step & 1) * RB_BYTES;
        LAS float* st = stats + (step & 1) * 512;
        f32x16 out[2]; u32x2 gt[2][4];
#pragma unroll
        for (int is = 0; is < 2; ++is)
#pragma unroll
            for (int g4 = 0; g4 < 4; ++g4) gt[is][g4] = *(const u32x2*)(RG + (size_t)(rc + 32 * is + ln) * 512 + head * 128 + 32 * slice + 8 * g4 + 4 * h);
#pragma unroll
        for (int is = 0; is < 2; ++is)
#pragma unroll
            for (int i = 0; i < 16; ++i) out[is][i] = 0.f;
        const LAS unsigned char* qrow = cur + RB_Q + ln * RB_ROW; const LAS unsigned char* krow = cur + RB_K + ln * RB_ROW;
#pragma unroll
        for (int ms = 0; ms < 4; ++ms)
#pragma unroll
            for (int s = 0; s < 2; ++s) {
                const bf16x8 tb = pack8(T[ms], s);
#pragma unroll
                for (int is = 0; is < 2; ++is) out[is] = MFMA32(tb, lds44(qrow + is * 32 * RB_ROW + (32 * ms + 16 * s + 4 * h) * 2, 16), out[is]);
            }
#pragma unroll
        for (int is = 0; is < 2; ++is) out[is] = out[is] * c;
#pragma unroll
        for (int blk = 0; blk < 3; ++blk) {
            const int js = blk == 2 ? 1 : 0, is = blk == 0 ? 0 : 1;
            f32x16 P;
#pragma unroll
            for (int i = 0; i < 16; ++i) P[i] = 0.f;
#pragma unroll
            for (int ks = 0; ks < 8; ++ks) P = MFMA32(lds8(krow + js * 32 * RB_ROW + (16 * ks + 8 * h) * 2), lds8(qrow + is * 32 * RB_ROW + (16 * ks + 8 * h) * 2), P);
            if (js == is) {
#pragma unroll
                for (int i = 0; i < 16; ++i) P[i] = (8 * (i >> 2) + 4 * h + (i & 3)) <= ln ? P[i] : 0.f;
            }
#pragma unroll
            for (int s = 0; s < 2; ++s) out[is] = MFMA32(lds44(cur + RB_VT + ((4 * js + 2 * s) * 128 + 32 * slice + ln) * 16 + 8 * h, 2048), pack8(P, s), out[is]);
        }
        {
            bf16x8 vfr[4];
#pragma unroll
            for (int ks = 0; ks < 4; ++ks) vfr[ks] = lds8(cur + RB_VT + ((2 * ks + h) * 128 + 32 * slice + ln) * 16);
#pragma unroll
            for (int ms = 0; ms < 4; ++ms) {
                T[ms] = T[ms] * c;
#pragma unroll
                for (int ks = 0; ks < 4; ++ks) T[ms] = MFMA32(lds8(cur + RB_KT + ((2 * ks + h) * 128 + 32 * ms + ln) * 16), vfr[ks], T[ms]);
            }
        }
#pragma unroll
        for (int is = 0; is < 2; ++is) {
            float s1 = 0.f, s2 = 0.f;
#pragma unroll
            for (int i = 0; i < 16; ++i) { s1 += out[is][i]; s2 += out[is][i] * out[is][i]; }
            s1 += __shfl_xor(s1, 32); s2 += __shfl_xor(s2, 32);
            if (h == 0) { st[slice * 128 + 2 * (32 * is + ln)] = s1; st[slice * 128 + 2 * (32 * is + ln) + 1] = s2; }
        }
        __syncthreads();
#pragma unroll
        for (int is = 0; is < 2; ++is) {
            float t1 = 0.f, t2 = 0.f;
#pragma unroll
            for (int sl = 0; sl < 4; ++sl) { t1 += st[sl * 128 + 2 * (32 * is + ln)]; t2 += st[sl * 128 + 2 * (32 * is + ln) + 1]; }
            const float mean = t1 * (1.f / 128.f), var = __builtin_fmaxf(t2 * (1.f / 128.f) - mean * mean, 0.f), rstd = __builtin_amdgcn_rsqf(var + EPS);
            const size_t row = (size_t)(rc + 32 * is + ln);
#pragma unroll
            for (int g4 = 0; g4 < 4; ++g4) {
                const int d0 = 32 * slice + 8 * g4 + 4 * h;
                const u32x2 gg = gt[is][g4];
                const float g0 = __builtin_bit_cast(float, gg.x << 16), g1 = __builtin_bit_cast(float, gg.x & 0xffff0000u), g2 = __builtin_bit_cast(float, gg.y << 16), g3 = __builtin_bit_cast(float, gg.y & 0xffff0000u);
                u32x2 w; w.x = pk2((out[is][4 * g4] - mean) * rstd * g0, (out[is][4 * g4 + 1] - mean) * rstd * g1);
                w.y = pk2((out[is][4 * g4 + 2] - mean) * rstd * g2, (out[is][4 * g4 + 3] - mean) * rstd * g3);
                *(u32x2*)(MIX + row * D + 512 + head * 128 + d0) = w;
            }
        }
        __syncthreads();
    }
    if (sout) {
        const float gsc = ex2(63.f * lg_gamma(head));
#pragma unroll
        for (int ms = 0; ms < 4; ++ms)
#pragma unroll
            for (int i = 0; i < 16; ++i) sout[(32 * ms + 8 * (i >> 2) + 4 * h + (i & 3)) * 128 + 32 * slice + ln] = T[ms][i] * gsc;
    }
}

#define RLX_AGENT __ATOMIC_RELAXED, __HIP_MEMORY_SCOPE_AGENT
#define XB_TMO      128
#define XB_XCNT(j)  (256  + 64 * (j))
#define XB_XSUB(j)  (1280 + 64 * (j))
#define XB_XGEN(j)  (2304 + 64 * (j))
#define XB_TOP      3328
#define XB_TOPGEN   3392
#define XCD_BAR_WORDS 3456
#define XB_SPIN_CAP (1u << 18)

__device__ __forceinline__ unsigned xb_ld(unsigned* p)              { return __hip_atomic_load(p, __ATOMIC_RELAXED, __HIP_MEMORY_SCOPE_AGENT); }
__device__ __forceinline__ unsigned xb_add(unsigned* p, unsigned v) { return __hip_atomic_fetch_add(p, v, __ATOMIC_RELAXED, __HIP_MEMORY_SCOPE_AGENT); }
__device__ __forceinline__ unsigned xb_xcc_id() { return (unsigned)__builtin_amdgcn_s_getreg((3 << 11) | 20) & 0xFu; }
#define XB_SPIN(cond, bar) do { unsigned _sp = 0; while (cond) { __builtin_amdgcn_s_sleep(1); \
    if ((++_sp & 255u) == 0u) { if (xb_ld(&(bar)[XB_TMO])) break; if (_sp > XB_SPIN_CAP) { atomicAdd(&(bar)[XB_TMO], 1u); break; } } } } while (0)

struct XcdBarrier {
    unsigned* bar; unsigned x;
    volatile LAS unsigned* st;
};

__device__ __forceinline__ XcdBarrier xcd_barrier_post(unsigned* bar, volatile LAS unsigned* st) {
    XcdBarrier b; b.bar = bar; b.x = xb_xcc_id(); b.st = st;
    if (threadIdx.x == 0) (void)xb_add(&bar[XB_XCNT(b.x)], 1u);
    return b;
}
__device__ __forceinline__ void xcd_barrier_complete(unsigned* bar, unsigned x, unsigned& nloc, unsigned& nx) {
    const unsigned G = gridDim.x * gridDim.y * gridDim.z;
    unsigned sum, cnt, mine, sp = 0u;
    for (;;) {
        sum = 0u; cnt = 0u; mine = 0u;
#pragma unroll
        for (unsigned j = 0; j < 16; ++j) { const unsigned c = xb_ld(&bar[XB_XCNT(j)]); sum += c; cnt += (c > 0u) ? 1u : 0u; mine = (j == x) ? c : mine; }
        if (sum == G) break;
        __builtin_amdgcn_s_sleep(1);
        if ((++sp & 255u) == 0u) { if (xb_ld(&bar[XB_TMO])) break; if (sp > XB_SPIN_CAP) { atomicAdd(&bar[XB_TMO], 1u); break; } }
    }
    nloc = mine > 0u ? mine : 1u; nx = cnt > 0u ? cnt : 1u;
}

__device__ __forceinline__ void xcd_barrier(const XcdBarrier& b) {
    asm volatile("s_waitcnt vmcnt(0)" ::: "memory");
    __syncthreads();
    if (threadIdx.x == 0) {
        unsigned* bar = b.bar;
        __builtin_amdgcn_s_waitcnt(0);
        unsigned nloc = b.st[0], nx = b.st[1];
        if (nloc == 0u) { xcd_barrier_complete(bar, b.x, nloc, nx); b.st[0] = nloc; b.st[1] = nx; }
        const unsigned old = xb_add(&bar[XB_XSUB(b.x)], 1u);
        const unsigned gen = old / nloc;
        if (old + 1u == (gen + 1u) * nloc) {
            __builtin_amdgcn_fence(__ATOMIC_RELEASE, "agent");
            asm volatile("s_waitcnt vmcnt(0)" ::: "memory");
            const unsigned og = xb_add(&bar[XB_TOP], 1u);
            const unsigned tg = og / nx;
            if (og + 1u == (tg + 1u) * nx) xb_add(&bar[XB_TOPGEN], 1u);
            else XB_SPIN(xb_ld(&bar[XB_TOPGEN]) == tg, bar);
            __builtin_amdgcn_fence(__ATOMIC_ACQUIRE, "agent");
            xb_add(&bar[XB_XGEN(b.x)], 1u);
            asm volatile("s_waitcnt vmcnt(0)" ::: "memory");
        } else {
            XB_SPIN(xb_ld(&bar[XB_XGEN(b.x)]) == gen, bar);
            __builtin_amdgcn_fence(__ATOMIC_ACQUIRE, "agent");
            asm volatile("s_waitcnt vmcnt(0)" ::: "memory");
        }
    }
    __syncthreads();
}

__global__ void __launch_bounds__(512, 2) fwd(Args a) {
    extern __shared__ __attribute__((aligned(16))) unsigned char lds_raw[];
    LAS unsigned char* lds = (LAS unsigned char*)lds_raw;
    cg::grid_group grid = cg::this_grid();
    const int tid0 = threadIdx.x;
    unsigned char* ws = a.ws;
    volatile LAS unsigned* bst = (volatile LAS unsigned*)(lds + LDS_BYTES - 64);
    if (tid0 < 2) bst[tid0] = 0u;
    __syncthreads();
    XcdBarrier bar; bar.bar = (unsigned*)(ws + WS_BAR); bar.x = 0; bar.st = bst;
    float* mod = (float*)(ws + WS_MOD);
    bf16_t* XN = (bf16_t*)(ws + WS_XN);
    constexpr int NPI = 12 + (PH_DUP >= 0 ? 1 : 0);
    for (int pi = 0; pi < NPI; ++pi) {
        const int ph = (PH_DUP >= 0 && pi > PH_DUP) ? pi - 1 : pi;
        int tid = tid0; asm volatile("" : "+v"(tid));
        const int lane = tid & 63, wave = __builtin_amdgcn_readfirstlane(tid >> 6);
        if (ph == 0 && PHON(0)) {
            p0_prologue(a, lds, tid, wave, lane, pi == 0);
        } else if ((ph == 1 || ph == 4 || ph == 9) && PHON(1)) {
            const float* sP = ph == 1 ? a.in[0] : a.out; const float* sS = ph == 1 ? a.in[1] : a.out + (size_t)MP * D;
            const float* gain = ph == 1 ? a.in[9] : ph == 4 ? a.in[10] : a.in[11];
            const int k = ph == 1 ? 0 : ph == 4 ? 3 : 6;
            if (ph == 1) norm_phase(sP, sS, nullptr, gain, mod, k * D, (k + 1) * D, XN, wave, lane);
            else norm_phase_b16((const bf16_t*)(ws + WS_XB), gain, mod, k * D, (k + 1) * D, XN, wave, lane);
        } else if ((ph == 2 || ph == 10) && PHON(2)) {
            pg8::Gemm g{XN, (const bf16_t*)(ws + (ph == 2 ? WS_WUP1 : WS_WUP2)), M, NUP, D, 0}; pg8::StaticOrder S; S.init(M, NUP, D, (int)gridDim.x, (int)blockIdx.x);
            EpiSwiGLU E{(bf16_t*)(ws + WS_ACT)};
            pg8::gemm_phase<EpiSwiGLU, pg8::StaticOrder, true, true>(lds, g, S, E);
        } else if ((ph == 3 || ph == 8 || ph == 11) && PHON(3)) {
            const bf16_t* A = (const bf16_t*)(ws + (ph == 8 ? WS_MIX : WS_ACT));
            const bf16_t* W = (const bf16_t*)(ws + (ph == 3 ? WS_WDN1 : ph == 8 ? WS_WOUT : WS_WDN2));
            pg8::Gemm g{A, W, M, D, ph == 8 ? D : FF, ph == 8 ? 0 : 1}; pg8::StaticOrder S; S.init(M, D, ph == 8 ? D : FF, (int)gridDim.x, (int)blockIdx.x);
            EpiResid E{a.in[0], a.in[1], a.out, mod, (ph == 3 ? 2 : ph == 8 ? 5 : 8) * D, ph == 8 ? 1.f : 0.5f, ph == 3 ? 0 : ph == 8 ? 1 : 2};
            pg8::gemm_phase<EpiResid, pg8::StaticOrder, true, true>(lds, g, S, E);
        } else if (ph == 5 && PHON(5)) {
            pg8::Gemm g{XN, (const bf16_t*)(ws + WS_WIN), M, NIN, D, 0}; pg8::StaticOrder S; S.init(M, NIN, D, (int)gridDim.x, (int)blockIdx.x);
            EpiIn E{a.in[15], a.in[16], (const f32x2*)(ws + WS_ROPE), a.out, ws};
            pg8::gemm_phase<EpiIn, pg8::StaticOrder, true, true>(lds, g, S, E);
        } else if (ph == 6 && PHON(6)) {
            unsigned* q = (unsigned*)(ws + WS_CTL) + 64 + 512 * (pi & 1);
            const int x0 = (int)(xb_xcc_id() & 7u);
            constexpr int QS = 64, QA = (16 * (NG - 1) * 4) / 8, QP = (MP / 32) * 8 / 8, QN = QS + QA + QP;
            for (int dx = 0; dx < 8; ++dx) {
                const int x = (x0 + dx) & 7;
                for (;;) {
                    unsigned k = 0;
                    if (lane == 0) k = __hip_atomic_fetch_add(q + 64 * x, 1u, __ATOMIC_RELAXED, __HIP_MEMORY_SCOPE_AGENT);
                    k = (unsigned)__builtin_amdgcn_readfirstlane((int)k);
                    if (k >= (unsigned)QN) break;
                    if (k >= (unsigned)QS && k < (unsigned)(QS + QA)) ret_passA(x * QA + (int)k - QS, ws, lane);
                    else sb_item(k < (unsigned)QS ? (MP / 32) * 8 + x * QS + (int)k : x * QP + (int)k - (QS + QA), a, lane);
                }
            }
        } else if (ph == 7 && PHON(7)) {
            const int G = (int)gridDim.x, nit = 16 * NG + 128;
            for (int k = 0;; ++k) {
                int bi;
                if (G == 16 * NG) { const int g = (int)blockIdx.x % NG; if (k == 0) bi = (int)blockIdx.x; else if (k == 1 && g < NG / 2) bi = 16 * NG + ((int)blockIdx.x / NG) * (NG / 2) + g; else break; }
                else { bi = (int)blockIdx.x + k * G; if (bi >= nit) break; }
                ret_block(bi >= 16 * NG, bi >= 16 * NG ? bi - 16 * NG : bi, a, lds, tid, wave, lane);
            }
        }
        if (pi == 0) { grid.sync(); bar = xcd_barrier_post((unsigned*)(ws + WS_BAR), bst); }
        else if (pi < NPI - 1) xcd_barrier(bar);
        if (PHREP(12)) xcd_barrier(bar);
    }
}
}

extern "C" void kernel_launch(void* const* d_in, const int* in_sizes, int n_in, void* d_out, int out_size, void* d_ws, size_t ws_size, hipStream_t stream) {
    static int grid = 0;
    if (grid == 0) {
        if (n_in != 20 || ws_size < mk::WS_END) { fprintf(stderr, "kernel_launch: unexpected inputs (n_in %d, ws %zu)\n", n_in, ws_size); grid = -1; return; }
        int dev = 0, cus = 0, per_cu = 0;
        hipGetDevice(&dev);
        hipDeviceGetAttribute(&cus, hipDeviceAttributeMultiprocessorCount, dev);
        hipFuncSetAttribute((const void*)mk::fwd, hipFuncAttributeMaxDynamicSharedMemorySize, mk::LDS_BYTES);
        hipOccupancyMaxActiveBlocksPerMultiprocessor(&per_cu, (const void*)mk::fwd, 512, mk::LDS_BYTES);
        if (per_cu < 1) per_cu = 1;
        grid = cus * per_cu;
        (void)hipGetLastError();
    }
    if (grid < 0) return;
    mk::Args a{};
    for (int i = 0; i < 20; ++i) a.in[i] = (const float*)d_in[i];
    a.out = (float*)d_out; a.ws = (unsigned char*)d_ws;
    void* args[] = {&a};
    hipError_t e = hipLaunchCooperativeKernel((const void*)mk::fwd, dim3(grid), dim3(512), args, mk::LDS_BYTES, stream);
    if (e != hipSuccess) fprintf(stderr, "cooperative launch failed: %s (grid %d)\n", hipGetErrorString(e), grid);
}
```

```cpp
#include <hip/hip_runtime.h>
#include <hip/hip_cooperative_groups.h>
#include <cstdio>
#include <cstdint>
namespace cg = cooperative_groups;
namespace pg8 {
#define PG8_LAS __attribute__((address_space(3)))
typedef unsigned short bf16_t;
typedef short bf16x8 __attribute__((ext_vector_type(8)));
typedef float f32x4 __attribute__((ext_vector_type(4)));
typedef unsigned u32x4 __attribute__((ext_vector_type(4)));
constexpr int BM = 256, BK = 64, HALF = 128, HTB = HALF * BK * 2  , STAGE_BYTES = 8 * HTB, NXCD = 8, WGM = 8;

__host__ __device__ __forceinline__ int lds_byte(int r, int c) { const int st = (r >> 4) * 2 + (c >> 5), rr = r & 15, cc = c & 31, ob = rr * 64 + cc * 2; return st * 1024 + (ob ^ (((ob >> 9) & 1) << 5)); }
__host__ __device__ __forceinline__ void stage_rc(int b, int& R, int& C) { const int st = b / 1024, sb = b % 1024, swz = sb ^ (((sb >> 9) & 1) << 5); R = (st >> 1) * 16 + swz / 64; C = (st & 1) * 32 + (swz % 64) / 2; }
__host__ __device__ __forceinline__ int perm32(int rho) { const int n = rho >> 4, i = rho & 15; return 8 * (i >> 2) + 4 * n + (i & 3); }

struct Unit { int pm, pn, kt0, nkt, aux; };
struct Gemm { const bf16_t* A; const bf16_t* Bt; int M, N, K; int a_blk; };

struct StaticOrder {
    int nM, nN, nwg, G, c, nt;
    __host__ __device__ void init(int M, int N, int K, int G_, int c_) { nM = M / BM; nN = N / BM; nwg = nM * nN; G = G_; c = c_; nt = K / BK; }
    __host__ __device__ bool next(int i, Unit& u) const {
        const long L = (long)i * G + c; if (L >= nwg) return false;
        int wgid = (int)L; { const int q = nwg / NXCD, r = nwg % NXCD, xcd = wgid % NXCD, off = wgid / NXCD; wgid = (xcd < r ? xcd * (q + 1) : r * (q + 1) + (xcd - r) * q) + off; }
        const int nig = WGM * nN, gid = wgid / nig, fm = gid * WGM, gsz = (nM - fm) < WGM ? (nM - fm) : WGM;
        u.pm = fm + ((wgid % nig) % gsz); u.pn = (wgid % nig) / gsz; u.kt0 = 0; u.nkt = nt; u.aux = 0; return true;
    }
    __device__ __forceinline__ void a_ready(const Unit&) const {}
    __device__ __forceinline__ void done(const Unit&) const {}
};
__device__ __forceinline__ unsigned cvt_pk_bf16(float lo, float hi) { unsigned r; asm volatile("v_cvt_pk_bf16_f32 %0, %1, %2" : "=v"(r) : "v"(lo), "v"(hi)); return r; }
template <class Epi, class Sched, bool ALIGN_EPI = false, bool SP2 = false>
__device__ __forceinline__ void gemm_phase(PG8_LAS unsigned char* lds, const Gemm g, const Sched& S, const Epi& E) {
    int tid_ = threadIdx.x; asm volatile("" : "+v"(tid_));
    const int tid = tid_, wid = __builtin_amdgcn_readfirstlane(tid >> 6), lane = tid & 63, wr = wid >> 2, wc = wid & 3, fr = lane & 15, fq = lane >> 4;
    const int K = g.K;
    unsigned voffA[2], voffB[2];
#pragma unroll
    for (int i = 0; i < 2; ++i) { int R, C; stage_rc(tid * 16 + i * 8192, R, C); const int Rb = Epi::PERM ? ((R & ~31) + perm32(R & 31)) : R;
        voffA[i] = (unsigned)(R * (g.a_blk ? BK : K) + C) * 2u; voffB[i] = (unsigned)(Rb * K + C) * 2u; }
    const size_t kstep = (size_t)(BK * 2);
    const size_t hstep = (size_t)HALF * K * 2;
    const size_t tstep = 2 * hstep;
    const size_t kstepA = g.a_blk ? (size_t)(BM * BK * 2) : kstep, hstepA = g.a_blk ? (size_t)(HALF * BK * 2) : hstep;
    const unsigned ldsw = (unsigned)wid * 1024u;
    const int aoff = lds_byte(wr * 64 + fr, fq * 8), boff = lds_byte(wc * 32 + fr, fq * 8);
#define PG8_SA(b, h) (((b) * 2 + (h)) * HTB)
#define PG8_SB(b, h) ((4 + (b) * 2 + (h)) * HTB)
#define PG8_STAGE(bufoff, gbase, voff) do { _Pragma("unroll") for (int _i = 0; _i < 2; ++_i) \
        __builtin_amdgcn_global_load_lds((const unsigned*)((const char*)(gbase) + (voff)[_i]), (PG8_LAS unsigned*)(lds + (bufoff) + ldsw + _i * 8192), 16, 0, 0); } while (0)
#define PG8_LDA(dst, b, h) do { _Pragma("unroll") for (int m = 0; m < 4; ++m) _Pragma("unroll") for (int k = 0; k < 2; ++k) dst[m][k] = *(const PG8_LAS bf16x8*)(lds + PG8_SA(b, h) + aoff + m * 2048 + k * 1024); } while (0)
#define PG8_LDB(dst, b, h) do { _Pragma("unroll") for (int n = 0; n < 2; ++n) _Pragma("unroll") for (int k = 0; k < 2; ++k) dst[n][k] = *(const PG8_LAS bf16x8*)(lds + PG8_SB(b, h) + boff + n * 2048 + k * 1024); } while (0)
#define PG8_MMA(ai, bj, At, Bt) do { __builtin_amdgcn_s_setprio(1); _Pragma("unroll") for (int m = 0; m < 4; ++m) _Pragma("unroll") for (int n = 0; n < 2; ++n) _Pragma("unroll") for (int k = 0; k < 2; ++k) \
        acc[ai][bj][m][n] = __builtin_amdgcn_mfma_f32_16x16x32_bf16(Bt[n][k], At[m][k], acc[ai][bj][m][n], 0, 0, 0); __builtin_amdgcn_s_setprio(0); } while (0)
#define PG8_WAIT_V(n) asm volatile("s_waitcnt vmcnt(" #n ")" ::: "memory")
#define PG8_WAIT_L(n) asm volatile("s_waitcnt lgkmcnt(" #n ")" ::: "memory")
#define PG8_BAR __builtin_amdgcn_s_barrier()
#define PG8_SCHED __builtin_amdgcn_sched_barrier(0)
    Unit cur, nxt; int ui = 0;
    if (!S.next(0, cur)) return;
    f32x4 acc[2][2][4][2];
#pragma unroll
    for (int a = 0; a < 2; ++a)
#pragma unroll
        for (int b = 0; b < 2; ++b)
#pragma unroll
            for (int m = 0; m < 4; ++m)
#pragma unroll
                for (int n = 0; n < 2; ++n) acc[a][b][m][n] = (f32x4){0.f, 0.f, 0.f, 0.f};
    bf16x8 At[4][2], B0[2][2], B1[2][2];
    const char* cA = (const char*)g.A + (size_t)cur.pm * tstep + (size_t)cur.kt0 * kstepA; const char* cB = (const char*)g.Bt + (size_t)cur.pn * tstep + (size_t)cur.kt0 * kstep;
    S.a_ready(cur);
    if constexpr (SP2) {
        PG8_STAGE(PG8_SB(0, 0), cB, voffB); PG8_STAGE(PG8_SB(0, 1), cB + hstep, voffB); PG8_STAGE(PG8_SA(0, 0), cA, voffA); PG8_STAGE(PG8_SA(0, 1), cA + hstepA, voffA);
        if (wr == 1) PG8_BAR;
        PG8_WAIT_V(2); PG8_BAR;
        PG8_STAGE(PG8_SB(1, 0), cB + kstep, voffB); PG8_STAGE(PG8_SA(1, 0), cA + kstepA, voffA); PG8_STAGE(PG8_SB(1, 1), cB + hstep + kstep, voffB);
        PG8_WAIT_V(6); PG8_BAR;
    } else {
        PG8_STAGE(PG8_SB(0, 0), cB, voffB); PG8_STAGE(PG8_SA(0, 0), cA, voffA); PG8_STAGE(PG8_SB(0, 1), cB + hstep, voffB); PG8_STAGE(PG8_SA(0, 1), cA + hstepA, voffA);
        if (wr == 1) PG8_BAR;
        PG8_WAIT_V(4); PG8_BAR;
        PG8_STAGE(PG8_SB(1, 0), cB + kstep, voffB); PG8_STAGE(PG8_SA(1, 0), cA + kstepA, voffA); PG8_STAGE(PG8_SB(1, 1), cB + hstep + kstep, voffB);
        PG8_WAIT_V(6); PG8_BAR;
    }
    for (;;) {
        const bool has_next = S.next(ui + 1, nxt);
        const char* nA = has_next ? (const char*)g.A + (size_t)nxt.pm * tstep + (size_t)nxt.kt0 * kstepA : cA; const char* nB = has_next ? (const char*)g.Bt + (size_t)nxt.pn * tstep + (size_t)nxt.kt0 * kstep : cB;
        const int nt = cur.nkt;
        for (int t = 0; t < nt; t += 2) {
            const bool last = (t == nt - 2);
            const char* a1 = cA + (size_t)(t + 1) * kstepA;
            const char* a2 = last ? nA : cA + (size_t)(t + 2) * kstepA; const char* b2 = last ? nB : cB + (size_t)(t + 2) * kstep;
            const char* a3 = a2 + kstepA; const char* b3 = b2 + kstep;
            if (last && has_next) S.a_ready(nxt);
            if constexpr (SP2) {
            PG8_LDB(B0, 0, 0); PG8_LDB(B1, 0, 1); PG8_SCHED; PG8_LDA(At, 0, 0); PG8_STAGE(PG8_SA(1, 1), a1 + hstepA, voffA);
            PG8_WAIT_V(8); PG8_WAIT_L(0); PG8_BAR; PG8_MMA(0, 0, At, B0); PG8_MMA(0, 1, At, B1); PG8_BAR; PG8_SCHED;
            PG8_LDA(At, 0, 1); PG8_STAGE(PG8_SB(0, 0), b2, voffB); PG8_STAGE(PG8_SB(0, 1), b2 + hstep, voffB); PG8_STAGE(PG8_SA(0, 0), a2, voffA);
            PG8_WAIT_V(8); PG8_WAIT_L(0); PG8_BAR; PG8_MMA(1, 0, At, B0); PG8_MMA(1, 1, At, B1); PG8_BAR; PG8_SCHED;
            PG8_LDB(B0, 1, 0); PG8_LDB(B1, 1, 1); PG8_SCHED; PG8_LDA(At, 1, 0); PG8_STAGE(PG8_SA(0, 1), a2 + hstepA, voffA);
            PG8_WAIT_V(8); PG8_WAIT_L(0); PG8_BAR; PG8_MMA(0, 0, At, B0); PG8_MMA(0, 1, At, B1); PG8_BAR; PG8_SCHED;
            PG8_LDA(At, 1, 1); PG8_STAGE(PG8_SB(1, 0), b3, voffB); PG8_STAGE(PG8_SB(1, 1), b3 + hstep, voffB); PG8_STAGE(PG8_SA(1, 0), a3, voffA);
            PG8_WAIT_V(8); PG8_WAIT_L(0); PG8_BAR; PG8_MMA(1, 0, At, B0); PG8_MMA(1, 1, At, B1); PG8_BAR; PG8_SCHED;
            } else {
            PG8_LDB(B0, 0, 0); PG8_SCHED; PG8_LDA(At, 0, 0); PG8_STAGE(PG8_SA(1, 1), a1 + hstepA, voffA);
            PG8_WAIT_L(8); PG8_BAR; PG8_WAIT_L(0); PG8_MMA(0, 0, At, B0); PG8_BAR; PG8_SCHED;
            PG8_LDB(B1, 0, 1); PG8_STAGE(PG8_SB(0, 0), b2, voffB);
            PG8_BAR; PG8_WAIT_L(0); PG8_MMA(0, 1, At, B1); PG8_BAR;
            PG8_LDA(At, 0, 1); PG8_STAGE(PG8_SA(0, 0), a2, voffA);
            PG8_BAR; PG8_WAIT_L(0); PG8_MMA(1, 0, At, B0); PG8_BAR; PG8_SCHED;
            PG8_STAGE(PG8_SB(0, 1), b2 + hstep, voffB);
            PG8_WAIT_V(6); PG8_BAR; PG8_MMA(1, 1, At, B1); PG8_BAR;
            PG8_LDB(B0, 1, 0); PG8_SCHED; PG8_LDA(At, 1, 0); PG8_STAGE(PG8_SA(0, 1), a2 + hstepA, voffA);
            PG8_WAIT_L(8); PG8_BAR; PG8_WAIT_L(0); PG8_MMA(0, 0, At, B0); PG8_BAR; PG8_SCHED;
            PG8_LDB(B1, 1, 1); PG8_STAGE(PG8_SB(1, 0), b3, voffB);
            PG8_BAR; PG8_WAIT_L(0); PG8_MMA(0, 1, At, B1); PG8_BAR;
            PG8_LDA(At, 1, 1); PG8_STAGE(PG8_SA(1, 0), a3, voffA);
            PG8_BAR; PG8_WAIT_L(0); PG8_MMA(1, 0, At, B0); PG8_BAR; PG8_SCHED;
            PG8_STAGE(PG8_SB(1, 1), b3 + hstep, voffB);
            PG8_WAIT_V(6); PG8_BAR; PG8_MMA(1, 1, At, B1); PG8_BAR;
            }
        }
        if constexpr (ALIGN_EPI) { if (wr == 0) PG8_BAR; }
        if constexpr (!Epi::AFTER_DRAIN) { E(acc, cur, wr, wc, fr, fq); S.done(cur); }
        if (!has_next) break;
#pragma unroll
        for (int a = 0; a < 2; ++a)
#pragma unroll
            for (int b = 0; b < 2; ++b)
#pragma unroll
                for (int m = 0; m < 4; ++m)
#pragma unroll
                    for (int n = 0; n < 2; ++n) acc[a][b][m][n] = (f32x4){0.f, 0.f, 0.f, 0.f};
        cur = nxt; cA = nA; cB = nB; ++ui;
        if constexpr (ALIGN_EPI) { if (wr == 1) PG8_BAR; }
    }
    PG8_WAIT_V(0);
    if constexpr (!ALIGN_EPI) { if (wr == 0) PG8_BAR; }
    PG8_BAR;
    if constexpr (Epi::AFTER_DRAIN) { E.fused(acc, cur, wr, wc, fr, fq, lds, wid, lane); S.done(cur); }
#undef PG8_SA
#undef PG8_SB
#undef PG8_STAGE
#undef PG8_LDA
#undef PG8_LDB
#undef PG8_MMA
#undef PG8_WAIT_V
#undef PG8_WAIT_L
#undef PG8_BAR
#undef PG8_SCHED
}
}

namespace mk {
using pg8::bf16_t; using pg8::bf16x8; using pg8::f32x4; using pg8::u32x4; using pg8::Unit;
#define DI __device__ __forceinline__
#define LAS __attribute__((address_space(3)))
typedef short s16x4 __attribute__((ext_vector_type(4)));
typedef float f32x16 __attribute__((ext_vector_type(16)));
typedef float f32x2 __attribute__((ext_vector_type(2)));
typedef unsigned u32x2 __attribute__((ext_vector_type(2)));
typedef __bf16 bf16x2_t __attribute__((ext_vector_type(2)));
#define MFMA32(a, b, c) __builtin_amdgcn_mfma_f32_32x32x16_bf16((a), (b), (c), 0, 0, 0)

constexpr int MP = 32768, MS = 2048, M = MP + MS, D = 1024, FF = 2816, NUP = 2 * FF, NIN = 3584, NMOD = 9 * D;
constexpr float EPS = 1e-6f, LOG2E = 1.4426950408889634f;
constexpr float QSCALE = 0.18033688011112042f;
constexpr float KSCALE = 0.08838834764831845f;
constexpr float SB_EXIT = 1e-30f;

constexpr size_t MiB = 1u << 20;
constexpr size_t WS_CTL = 0, WS_BAR = 65536, WS_MOD = 1 * MiB, WS_ROPE = 4 * MiB;
constexpr size_t WS_WUP1 = 8 * MiB, WS_WDN1 = 19 * MiB, WS_WIN = 25 * MiB, WS_WOUT = 32 * MiB, WS_WUP2 = 34 * MiB, WS_WDN2 = 45 * MiB;
constexpr size_t WS_XN = 60 * MiB, WS_BIG = 128 * MiB;
constexpr size_t WS_ACT = WS_BIG;
constexpr size_t WS_SBQ = WS_BIG, WS_SBK = WS_BIG + 34 * MiB, WS_SBVT = WS_BIG + 68 * MiB, WS_RQ = WS_BIG + 102 * MiB, WS_RK = WS_BIG + 136 * MiB,
                 WS_RKT = WS_BIG + 170 * MiB, WS_RVT = WS_BIG + 204 * MiB, WS_RG = WS_BIG + 238 * MiB, WS_MIX = WS_XN  , WS_LT = WS_BIG + 272 * MiB, WS_XB = WS_BIG + 288 * MiB, WS_END = WS_BIG + 356 * MiB;
constexpr int NG = 16, CG = 8;
constexpr size_t O_Y = 0, O_KP = 35651584, O_VP = 52428800, O_SP = 69206016, O_KS = 69468160, O_VS = 70516736, O_SS = 71565312;

constexpr int LDS_BYTES = 147456;
#ifndef PH_MASK
#define PH_MASK 0xFFF
#endif
#define PHON(k) ((PH_MASK >> (k)) & 1)
#ifndef PH_REP
#define PH_REP 0
#endif
#ifndef PH_DUP
#define PH_DUP -1
#endif
#define PHREP(k) ((PH_REP >> (k)) & 1)

DI unsigned pk2(float lo, float hi) { f32x2 v = {lo, hi}; bf16x2_t b = __builtin_convertvector(v, bf16x2_t); return __builtin_bit_cast(unsigned, b); }
DI float bf2f(unsigned short s) { return __builtin_bit_cast(float, (unsigned)s << 16); }
DI f32x4 bf4(u32x2 w) { f32x4 r; r[0] = __builtin_bit_cast(float, w.x << 16); r[1] = __builtin_bit_cast(float, w.x & 0xffff0000u); r[2] = __builtin_bit_cast(float, w.y << 16); r[3] = __builtin_bit_cast(float, w.y & 0xffff0000u); return r; }
DI int row_batch(int r) { return r < MP ? (r >> 13) : 4 + ((r - MP) >> 6); }
DI int row_pos(int r) { return r < MP ? (r & 8191) : 2048 + ((r - MP) & 63); }
DI float lg_gamma(int head) { return head == 0 ? -0.04580368961312479f : head == 1 ? -0.02272007650008353f : head == 2 ? -0.011315313227834146f : -0.005646563141142063f; }
DI float ex2(float x) { return __builtin_amdgcn_exp2f(x); }
DI float siluf(float g) { return g * __builtin_amdgcn_rcpf(1.f + ex2(-g * LOG2E)); }
DI float wave_sum(float v) {
#pragma unroll
    for (int o = 1; o < 64; o <<= 1) v += __shfl_xor(v, o);
    return v;
}
DI bf16x8 pack8(const f32x16& x, int s) {
    u32x4 p; p.x = pk2(x[8 * s], x[8 * s + 1]); p.y = pk2(x[8 * s + 2], x[8 * s + 3]); p.z = pk2(x[8 * s + 4], x[8 * s + 5]); p.w = pk2(x[8 * s + 6], x[8 * s + 7]);
    return __builtin_bit_cast(bf16x8, p);
}
DI bf16x8 ld8(const bf16_t* p) { return *(const bf16x8*)p; }
DI bf16x8 ld44(const bf16_t* p, int stride = 8) {
    const s16x4 lo = *(const s16x4*)p, hi = *(const s16x4*)(p + stride);
    return __builtin_shufflevector(lo, hi, 0, 1, 2, 3, 4, 5, 6, 7);
}

DI u32x4 tr8x8(u32x4 w, int lane) {
    { const bool b = (lane & 4) != 0;
      const unsigned s0 = b ? w.x : w.z, s1 = b ? w.y : w.w, r0 = __shfl_xor(s0, 4), r1 = __shfl_xor(s1, 4);
      if (b) { w.x = r0; w.y = r1; } else { w.z = r0; w.w = r1; } }
    { const bool b = (lane & 2) != 0;
      const unsigned s0 = b ? w.x : w.y, s1 = b ? w.z : w.w, r0 = __shfl_xor(s0, 2), r1 = __shfl_xor(s1, 2);
      if (b) { w.x = r0; w.z = r1; } else { w.y = r0; w.w = r1; } }
    { const bool b = (lane & 1) != 0;
      const unsigned p0 = __shfl_xor(w.x, 1), p1 = __shfl_xor(w.y, 1), p2 = __shfl_xor(w.z, 1), p3 = __shfl_xor(w.w, 1);
      if (b) { w.x = (p0 >> 16) | (w.x & 0xffff0000u); w.y = (p1 >> 16) | (w.y & 0xffff0000u); w.z = (p2 >> 16) | (w.z & 0xffff0000u); w.w = (p3 >> 16) | (w.w & 0xffff0000u); }
      else   { w.x = (w.x & 0xffffu) | (p0 << 16); w.y = (w.y & 0xffffu) | (p1 << 16); w.z = (w.z & 0xffffu) | (p2 << 16); w.w = (w.w & 0xffffu) | (p3 << 16); } }
    return w;
}

struct EpiSwiGLU {
    static constexpr bool PERM = true, AFTER_DRAIN = false;
    bf16_t* O;
    DI void operator()(const f32x4 (&acc)[2][2][4][2], const Unit& u, int wr, int wc, int fr, int fq) const {
        asm volatile("" : "+v"(fr), "+v"(fq));
        const int rl0 = wr * 64 + fr, kt = 2 * u.pn + (wc >> 1), cin = 32 * (wc & 1) + 8 * fq;
        bf16_t* blk = O + ((size_t)(u.pm * (FF / 64) + kt) * 256) * 64 + cin;
#pragma unroll
        for (int ai = 0; ai < 2; ++ai)
#pragma unroll
            for (int m = 0; m < 4; ++m) {
                const f32x4 g0 = acc[ai][0][m][0], g1 = acc[ai][0][m][1], u0 = acc[ai][1][m][0], u1 = acc[ai][1][m][1];
                u32x4 w;
                w.x = pk2(siluf(g0[0]) * u0[0], siluf(g0[1]) * u0[1]); w.y = pk2(siluf(g0[2]) * u0[2], siluf(g0[3]) * u0[3]);
                w.z = pk2(siluf(g1[0]) * u1[0], siluf(g1[1]) * u1[1]); w.w = pk2(siluf(g1[2]) * u1[2], siluf(g1[3]) * u1[3]);
                *(u32x4*)(blk + (size_t)(rl0 + ai * 128 + m * 16) * 64) = w;
            }
    }
};
struct EpiResid {
    static constexpr bool PERM = true, AFTER_DRAIN = false;
    const float* baseP; const float* baseS; float* out; const float* mod; int gofs; float gscale; int mode;
    DI void operator()(const f32x4 (&acc)[2][2][4][2], const Unit& u, int wr, int wc, int fr, int fq) const {
        asm volatile("" : "+v"(fr), "+v"(fq));
        const int row0 = u.pm * 256 + wr * 64 + fr, col0 = u.pn * 256 + wc * 32 + 8 * fq;
        bf16_t* xb = (bf16_t*)((unsigned char*)const_cast<float*>(mod) + (WS_XB - WS_MOD));
#pragma unroll
        for (int ai = 0; ai < 2; ++ai) {
            const float* mb = mod + (size_t)row_batch(u.pm * 256 + ai * 128 + wr * 64) * NMOD + gofs;
            f32x4 gv[2][2];
#pragma unroll
            for (int bj = 0; bj < 2; ++bj)
#pragma unroll
                for (int n = 0; n < 2; ++n) gv[bj][n] = *(const f32x4*)(mb + col0 + bj * 128 + n * 4) * gscale;
#pragma unroll
            for (int m = 0; m < 4; ++m) {
                const int row = row0 + ai * 128 + m * 16;
                f32x4 bv[2][2];
                if (mode == 0) {
                    const float* bp = row < MP ? baseP + (size_t)row * D : baseS + (size_t)(row - MP) * D;
#pragma unroll
                    for (int bj = 0; bj < 2; ++bj)
#pragma unroll
                        for (int n = 0; n < 2; ++n) bv[bj][n] = *(const f32x4*)(bp + col0 + bj * 128 + n * 4);
                } else {
#pragma unroll
                    for (int bj = 0; bj < 2; ++bj) { const u32x4 w = *(const u32x4*)(xb + (size_t)row * D + col0 + bj * 128);
                        u32x2 t; t.x = w.x; t.y = w.y; bv[bj][0] = bf4(t); t.x = w.z; t.y = w.w; bv[bj][1] = bf4(t); }
                }
#pragma unroll
                for (int bj = 0; bj < 2; ++bj) {
                    const f32x4 o0 = bv[bj][0] + gv[bj][0] * acc[ai][bj][m][0], o1 = bv[bj][1] + gv[bj][1] * acc[ai][bj][m][1];
                    if (mode == 2) { float* op = out + (size_t)row * D + col0 + bj * 128; *(f32x4*)op = o0; *(f32x4*)(op + 4) = o1; }
                    else { u32x4 w; w.x = pk2(o0[0], o0[1]); w.y = pk2(o0[2], o0[3]); w.z = pk2(o1[0], o1[1]); w.w = pk2(o1[2], o1[3]); *(u32x4*)(xb + (size_t)row * D + col0 + bj * 128) = w; }
                }
            }
        }
    }
};
struct EpiIn {
    static constexpr bool PERM = true, AFTER_DRAIN = false;
    const float* gq; const float* gk; const f32x2* tab;
    float* outf;
    unsigned char* ws;
    DI void operator()(const f32x4 (&acc)[2][2][4][2], const Unit& u, int wr, int wc, int fr, int fq) const {
        asm volatile("" : "+v"(fr), "+v"(fq));
        const int pn = u.pn, rbase = u.pm * 256 + wr * 64 + fr, e0 = 8 * fq;
        if (pn < 4) {
            const bool isk = pn >= 2; const int head = 4 * (pn & 1) + wc;
            const float* gain = isk ? gk : gq;
            f32x4 gv[2][2];
#pragma unroll
            for (int bj = 0; bj < 2; ++bj)
#pragma unroll
                for (int n = 0; n < 2; ++n) gv[bj][n] = *(const f32x4*)(gain + 32 * bj + e0 + 4 * n);
            bf16_t* ob = (bf16_t*)(ws + (isk ? WS_SBK : WS_SBQ));
#pragma unroll
            for (int ai = 0; ai < 2; ++ai)
#pragma unroll
                for (int m = 0; m < 4; ++m) {
                    const int row = rbase + ai * 128 + m * 16;
                    float ss = 0.f;
#pragma unroll
                    for (int bj = 0; bj < 2; ++bj)
#pragma unroll
                        for (int n = 0; n < 2; ++n) { const f32x4 x = acc[ai][bj][m][n]; ss += (x[0] * x[0] + x[1] * x[1]) + (x[2] * x[2] + x[3] * x[3]); }
                    ss += __shfl_xor(ss, 16); ss += __shfl_xor(ss, 32);
                    float inv = __builtin_amdgcn_rsqf(ss * (1.f / 64.f) + EPS);
                    const float invq = isk ? inv : inv * QSCALE;
#pragma unroll
                    for (int bj = 0; bj < 2; ++bj) {
                        const f32x4 v0 = acc[ai][bj][m][0] * gv[bj][0], v1 = acc[ai][bj][m][1] * gv[bj][1];
                        const f32x4 w0 = v0 * invq, w1 = v1 * invq;
                        u32x4 w; w.x = pk2(w0[0], w0[1]); w.y = pk2(w0[2], w0[3]); w.z = pk2(w1[0], w1[1]); w.w = pk2(w1[2], w1[3]);
                        *(u32x4*)(ob + (size_t)row * 512 + head * 64 + 32 * bj + e0) = w;
                        if (isk) {
                            float* o = (row < MP ? outf + O_KP + (size_t)row * 512 : outf + O_KS + (size_t)(row - MP) * 512) + head * 64 + 32 * bj + e0;
                            *(f32x4*)o = w0; *(f32x4*)(o + 4) = w1;
                        }
                    }
                }
        } else if (pn < 6) {
            const int head = 4 * (pn - 4) + wc;
            bf16_t* vt = (bf16_t*)(ws + WS_SBVT);
#pragma unroll
            for (int ai = 0; ai < 2; ++ai)
#pragma unroll
                for (int m = 0; m < 4; ++m) {
                    const int row = rbase + ai * 128 + m * 16;
                    float* o = (row < MP ? outf + O_VP + (size_t)row * 512 : outf + O_VS + (size_t)(row - MP) * 512) + head * 64 + e0;
                    bf16_t* t = vt + (((size_t)((row >> 5) * 8 + head) * 4 + ((row >> 3) & 3)) * 64 + e0 + (fr & 7)) * 8;
#pragma unroll
                    for (int bj = 0; bj < 2; ++bj) {
                        const f32x4 x0 = acc[ai][bj][m][0], x1 = acc[ai][bj][m][1];
                        *(f32x4*)(o + 32 * bj) = x0; *(f32x4*)(o + 32 * bj + 4) = x1;
                        u32x4 w; w.x = pk2(x0[0], x0[1]); w.y = pk2(x0[2], x0[3]); w.z = pk2(x1[0], x1[1]); w.w = pk2(x1[2], x1[3]);
                        *(u32x4*)(t + 32 * bj * 8) = tr8x8(w, fr);
                    }
                }
        } else {
            const int q = pn - 6, kind = q >> 1, head = 2 * (q & 1) + (wc >> 1), f0 = 32 * (wc & 1) + e0;
            const float lg = lg_gamma(head);
            if (kind <= 1) {
                bf16_t* ob = (bf16_t*)(ws + (kind ? WS_RK : WS_RQ));
                bf16_t* kt = (bf16_t*)(ws + WS_RKT);
#pragma unroll
                for (int ai = 0; ai < 2; ++ai)
#pragma unroll
                    for (int m = 0; m < 4; ++m) {
                        asm volatile("" ::: "memory");
                        const int row = rbase + ai * 128 + m * 16, pos = row_pos(row), ic = pos & 63;
                        const float sc = kind ? KSCALE * ex2(-(float)ic * lg) : ex2((float)ic * lg);
                        const f32x4* tp = (const f32x4*)(tab + (size_t)pos * 64 + f0);
                        f32x4 o1[2], o2[2];
#pragma unroll
                        for (int n = 0; n < 2; ++n) {
                            const f32x4 t0 = tp[2 * n], t1 = tp[2 * n + 1];
                            const f32x4 x1 = acc[ai][0][m][n], x2 = acc[ai][1][m][n];
                            const f32x4 cc = {t0[0], t0[2], t1[0], t1[2]}, sn = {t0[1], t0[3], t1[1], t1[3]};
                            o1[n] = (x1 * cc - x2 * sn) * sc; o2[n] = (x1 * sn + x2 * cc) * sc;
                        }
                        u32x4 w1, w2;
                        w1.x = pk2(o1[0][0], o1[0][1]); w1.y = pk2(o1[0][2], o1[0][3]); w1.z = pk2(o1[1][0], o1[1][1]); w1.w = pk2(o1[1][2], o1[1][3]);
                        w2.x = pk2(o2[0][0], o2[0][1]); w2.y = pk2(o2[0][2], o2[0][3]); w2.z = pk2(o2[1][0], o2[1][1]); w2.w = pk2(o2[1][2], o2[1][3]);
                        bf16_t* p = ob + (size_t)row * 512 + head * 128 + f0;
                        *(u32x4*)p = w1; *(u32x4*)(p + 64) = w2;
                        asm volatile("" ::: "memory");
                        if (kind) {
                            bf16_t* t = kt + (((size_t)((row >> 6) * 4 + head) * 8 + ((row >> 3) & 7)) * 128 + f0 + (fr & 7)) * 8;
                            *(u32x4*)t = tr8x8(w1, fr); *(u32x4*)(t + 64 * 8) = tr8x8(w2, fr);
                        }
                    }
            } else if (kind == 2) {
                bf16_t* vt = (bf16_t*)(ws + WS_RVT);
#pragma unroll
                for (int ai = 0; ai < 2; ++ai)
#pragma unroll
                    for (int m = 0; m < 4; ++m) {
                        const int row = rbase + ai * 128 + m * 16;
                        bf16_t* t = vt + (((size_t)((row >> 6) * 4 + head) * 8 + ((row >> 3) & 7)) * 128 + f0 + (fr & 7)) * 8;
#pragma unroll
                        for (int bj = 0; bj < 2; ++bj) {
                            const f32x4 x0 = acc[ai][bj][m][0], x1 = acc[ai][bj][m][1];
                            u32x4 w; w.x = pk2(x0[0], x0[1]); w.y = pk2(x0[2], x0[3]); w.z = pk2(x1[0], x1[1]); w.w = pk2(x1[2], x1[3]);
                            *(u32x4*)(t + 64 * bj * 8) = tr8x8(w, fr);
                        }
                    }
            } else {
                bf16_t* ob = (bf16_t*)(ws + WS_RG);
#pragma unroll
                for (int ai = 0; ai < 2; ++ai)
#pragma unroll
                    for (int m = 0; m < 4; ++m) {
                        const int row = rbase + ai * 128 + m * 16;
#pragma unroll
                        for (int bj = 0; bj < 2; ++bj) {
                            const f32x4 x0 = acc[ai][bj][m][0], x1 = acc[ai][bj][m][1];
                            u32x4 w; w.x = pk2(siluf(x0[0]), siluf(x0[1])); w.y = pk2(siluf(x0[2]), siluf(x0[3])); w.z = pk2(siluf(x1[0]), siluf(x1[1])); w.w = pk2(siluf(x1[2]), siluf(x1[3]));
                            *(u32x4*)(ob + (size_t)row * 512 + head * 128 + 64 * bj + f0) = w;
                        }
                    }
            }
        }
    }
};

DI int srccol_in(int cp) {
    const int pn = cp >> 8, loc = cp & 255, bj = loc >> 7, wc = (loc & 127) >> 5;
    if (pn < 6) { const int seg = pn >> 1, pp = pn & 1; return seg * 512 + 64 * (4 * pp + wc) + 32 * bj; }
    const int q = pn - 6, seg = q >> 1, pp = q & 1; return 1536 + seg * 512 + 128 * (2 * pp + (wc >> 1)) + 64 * bj + 32 * (wc & 1);
}
DI int srccol_up(int cp) { const int pn = cp >> 8, bj = (cp >> 7) & 1, i = cp & 127; return bj * FF + 128 * pn + i; }

DI void p0_transpose_item(const float* W, int K, int N, int srcc, bf16_t* WT, int dstr, int k0, LAS float* scr, int lane) {
#pragma unroll 8
    for (int i = 0; i < 32; ++i) { const int kk = 2 * i + (lane >> 5); scr[kk * 33 + (lane & 31)] = W[(size_t)(k0 + kk) * N + srcc + (lane & 31)]; }
    asm volatile("s_waitcnt lgkmcnt(0)" ::: "memory");
    const int c = lane & 7;
#pragma unroll
    for (int j = 0; j < 4; ++j) { const int n = (lane >> 3) + 8 * j; const LAS float* s = scr + (8 * c) * 33 + n;
        u32x4 o; o.x = pk2(s[0 * 33], s[1 * 33]); o.y = pk2(s[2 * 33], s[3 * 33]); o.z = pk2(s[4 * 33], s[5 * 33]); o.w = pk2(s[6 * 33], s[7 * 33]);
        *(u32x4*)(WT + (size_t)(dstr + n) * K + k0 + 8 * c) = o; }
    asm volatile("s_waitcnt lgkmcnt(0)" ::: "memory");
}
DI void ada_item(int it, const float* cP, const float* cS, const float* wada, const float* bada, float* mod, LAS float* red, int tid, int wave, int lane) {
    const int c0 = it * 64;
    LAS float* cs = red + wave * (64 * 36);
    float acc[36];
#pragma unroll
    for (int b = 0; b < 36; ++b) acc[b] = 0.f;
#pragma unroll 1
    for (int u = 0; u < 2; ++u) {
        const int kb = 128 * wave + 64 * u;
#pragma unroll 4
        for (int b = 0; b < 36; ++b) { const float cv = b < 4 ? cP[b * 1024 + kb + lane] : cS[(b - 4) * 1024 + kb + lane]; cs[lane * 36 + b] = cv / (1.f + __expf(-cv)); }
        asm volatile("s_waitcnt lgkmcnt(0)" ::: "memory");
#pragma unroll 1
        for (int k8 = 0; k8 < 8; ++k8) {
            float wv[8];
#pragma unroll
            for (int j = 0; j < 8; ++j) wv[j] = wada[(size_t)(kb + 8 * k8 + j) * NMOD + c0 + lane];
#pragma unroll
            for (int j = 0; j < 8; ++j) {
                const LAS f32x4* cr = (const LAS f32x4*)(cs + (8 * k8 + j) * 36);
#pragma unroll
                for (int q = 0; q < 9; ++q) { const f32x4 c4 = cr[q]; acc[4 * q] += c4[0] * wv[j]; acc[4 * q + 1] += c4[1] * wv[j]; acc[4 * q + 2] += c4[2] * wv[j]; acc[4 * q + 3] += c4[3] * wv[j]; }
            }
        }
        asm volatile("s_waitcnt lgkmcnt(0)" ::: "memory");
    }
    __syncthreads();
#pragma unroll
    for (int b = 0; b < 36; ++b) red[(wave * 36 + b) * 64 + lane] = acc[b];
    __syncthreads();
    for (int o = tid; o < 36 * 64; o += 512) {
        const int b = o >> 6, l = o & 63; float s = 0.f;
#pragma unroll
        for (int w = 0; w < 8; ++w) s += red[(w * 36 + b) * 64 + l];
        mod[(size_t)b * NMOD + c0 + l] = s + bada[c0 + l];
    }
    __syncthreads();
}

struct Args {
    const float* in[20]; float* out; unsigned char* ws;
};

DI void p0_prologue(const Args& a, LAS unsigned char* lds, int tid, int wave, int lane, bool first) {
    unsigned char* ws = a.ws;
    if (blockIdx.x == 0 && first) { for (int i = tid; i < 8192; i += 512) ((unsigned*)(ws + WS_CTL))[i] = 0u; for (int i = tid; i < 4096; i += 512) ((unsigned*)(ws + WS_BAR))[i] = 0u; }
    for (int it = blockIdx.x; it < NMOD / 64; it += gridDim.x)
        ada_item(it, a.in[5], a.in[6], a.in[7], a.in[8], (float*)(ws + WS_MOD), (LAS float*)lds, tid, wave, lane);
    for (int idx = blockIdx.x * 512 + tid; idx < 8192 * 64; idx += gridDim.x * 512) {
        const int pos = idx >> 6, f = idx & 63;
        const double xd = -(double)f * 0.20762050593046014; const double nf = __builtin_floor(xd);
        const float fr = (float)(xd - nf);
        const float ifr = __builtin_ldexpf(ex2(fr), (int)nf);
        const double rev = (double)pos * (double)ifr * 0.15915494309189535; const float frac = (float)(rev - __builtin_floor(rev));
        f32x2 cs; cs.x = __builtin_amdgcn_cosf(frac); cs.y = __builtin_amdgcn_sinf(frac);
        ((f32x2*)(ws + WS_ROPE))[idx] = cs;
    }
    LAS float* scr = (LAS float*)(lds + wave * 16384);
    const int gw = blockIdx.x * 8 + wave, NGW = gridDim.x * 8;
    constexpr int I_UP = (D / 64) * (NUP / 32), I_DN = (FF / 64) * (D / 32), I_IN = (D / 64) * (NIN / 32), I_OUT = (D / 64) * (D / 32);
    constexpr int NITEMS = 2 * I_UP + 2 * I_DN + I_IN + I_OUT;
    for (int it = gw; it < NITEMS; it += NGW) {
        int r = it;
        if (r < 2 * I_UP) { const int which = r >= I_UP; r -= which * I_UP; const int nb = r % (NUP / 32), kb = r / (NUP / 32);
            p0_transpose_item(a.in[which ? 18 : 12], D, NUP, srccol_up(32 * nb), (bf16_t*)(ws + (which ? WS_WUP2 : WS_WUP1)), 32 * nb, 64 * kb, scr, lane); continue; }
        r -= 2 * I_UP;
        if (r < 2 * I_DN) { const int which = r >= I_DN; r -= which * I_DN; const int nb = r % (D / 32), kb = r / (D / 32);
            p0_transpose_item(a.in[which ? 19 : 13], FF, D, 32 * nb, (bf16_t*)(ws + (which ? WS_WDN2 : WS_WDN1)), 32 * nb, 64 * kb, scr, lane); continue; }
        r -= 2 * I_DN;
        if (r < I_IN) { const int nb = r % (NIN / 32), kb = r / (NIN / 32);
            p0_transpose_item(a.in[14], D, NIN, srccol_in(32 * nb), (bf16_t*)(ws + WS_WIN), 32 * nb, 64 * kb, scr, lane); continue; }
        r -= I_IN;
        { const int nb = r % (D / 32), kb = r / (D / 32);
            p0_transpose_item(a.in[17], D, D, 32 * nb, (bf16_t*)(ws + WS_WOUT), 32 * nb, 64 * kb, scr, lane); }
    }
}

DI void norm_finish(int m, const f32x4 (&v)[4], float s, const float* gain, const float* mod, int shofs, int scofs, bf16_t* XN, int lane) {
    const float* mb = mod + (size_t)row_batch(m) * NMOD;
    const float inv = __builtin_amdgcn_rsqf(s * (1.f / D) + EPS);
    u32x2* o8 = (u32x2*)(XN + (size_t)m * D) + lane;
#pragma unroll
    for (int j = 0; j < 4; ++j) {
        const int c = 4 * (64 * j + lane);
        const f32x4 g4 = *(const f32x4*)(gain + c), sc4 = *(const f32x4*)(mb + scofs + c), sh4 = *(const f32x4*)(mb + shofs + c);
        const f32x4 o = v[j] * inv * g4 * (sc4 + 1.f) + sh4;
        u32x2 w; w.x = pk2(o[0], o[1]); w.y = pk2(o[2], o[3]); o8[64 * j] = w;
    }
}
DI void norm_phase(const float* srcP, const float* srcS, const bf16_t* srcB, const float* gain, const float* mod, int shofs, int scofs, bf16_t* XN, int wave, int lane) {
    const int gw = blockIdx.x * 8 + wave, NGW = gridDim.x * 8;
    for (int m = gw; m < M; m += 2 * NGW) {
        const int m2 = m + NGW; const bool two = m2 < M; const int mb2 = two ? m2 : m;
        const f32x4* xa = (const f32x4*)(m < MP ? srcP + (size_t)m * D : srcS + (size_t)(m - MP) * D) + lane;
        const f32x4* xb = (const f32x4*)(mb2 < MP ? srcP + (size_t)mb2 * D : srcS + (size_t)(mb2 - MP) * D) + lane;
        f32x4 va[4], vb[4]; float sa = 0.f, sb = 0.f;
        if (srcB) {
            const u32x2* ba = (const u32x2*)(srcB + (size_t)m * D) + lane; const u32x2* bb = (const u32x2*)(srcB + (size_t)mb2 * D) + lane;
#pragma unroll
            for (int j = 0; j < 4; ++j) { va[j] = bf4(ba[64 * j]); vb[j] = bf4(bb[64 * j]); }
        } else {
#pragma unroll
            for (int j = 0; j < 4; ++j) { va[j] = xa[64 * j]; vb[j] = xb[64 * j]; }
        }
#pragma unroll
        for (int j = 0; j < 4; ++j) { sa += (va[j][0] * va[j][0] + va[j][1] * va[j][1]) + (va[j][2] * va[j][2] + va[j][3] * va[j][3]); sb += (vb[j][0] * vb[j][0] + vb[j][1] * vb[j][1]) + (vb[j][2] * vb[j][2] + vb[j][3] * vb[j][3]); }
#pragma unroll
        for (int o = 1; o < 64; o <<= 1) { sa += __shfl_xor(sa, o); sb += __shfl_xor(sb, o); }
        norm_finish(m, va, sa, gain, mod, shofs, scofs, XN, lane);
        if (two) norm_finish(m2, vb, sb, gain, mod, shofs, scofs, XN, lane);
    }
}

DI void norm_row16_finish(int m, const f32x4 (&v)[4], float s, const float* gain, const float* mod, int shofs, int scofs, bf16_t* XN, int lane) {
    const float* mb = mod + (size_t)row_batch(m) * NMOD;
    const float inv = __builtin_amdgcn_rsqf(s * (1.f / D) + EPS);
#pragma unroll
    for (int j = 0; j < 2; ++j) {
        const int c = 8 * (64 * j + lane);
        u32x4 w;
#pragma unroll
        for (int q = 0; q < 2; ++q) {
            const f32x4 g4 = *(const f32x4*)(gain + c + 4 * q), sc4 = *(const f32x4*)(mb + scofs + c + 4 * q), sh4 = *(const f32x4*)(mb + shofs + c + 4 * q);
            const f32x4 o = v[2 * j + q] * inv * g4 * (sc4 + 1.f) + sh4;
            if (q == 0) { w.x = pk2(o[0], o[1]); w.y = pk2(o[2], o[3]); } else { w.z = pk2(o[0], o[1]); w.w = pk2(o[2], o[3]); }
        }
        *(u32x4*)(XN + (size_t)m * D + c) = w;
    }
}
DI void norm_phase_b16(const bf16_t* src, const float* gain, const float* mod, int shofs, int scofs, bf16_t* XN, int wave, int lane) {
    const int gw = blockIdx.x * 8 + wave, NGW = gridDim.x * 8;
    for (int m = gw; m < M; m += 2 * NGW) {
        const int m2 = m + NGW; const bool two = m2 < M; const int mb2 = two ? m2 : m;
        f32x4 va[4], vb[4]; float sa = 0.f, sb = 0.f;
#pragma unroll
        for (int j = 0; j < 2; ++j) {
            const u32x4 a = *(const u32x4*)(src + (size_t)m * D + 8 * (64 * j + lane)), b = *(const u32x4*)(src + (size_t)mb2 * D + 8 * (64 * j + lane));
            u32x2 t; t.x = a.x; t.y = a.y; va[2 * j] = bf4(t); t.x = a.z; t.y = a.w; va[2 * j + 1] = bf4(t);
            t.x = b.x; t.y = b.y; vb[2 * j] = bf4(t); t.x = b.z; t.y = b.w; vb[2 * j + 1] = bf4(t);
        }
#pragma unroll
        for (int j = 0; j < 4; ++j) { sa += (va[j][0] * va[j][0] + va[j][1] * va[j][1]) + (va[j][2] * va[j][2] + va[j][3] * va[j][3]); sb += (vb[j][0] * vb[j][0] + vb[j][1] * vb[j][1]) + (vb[j][2] * vb[j][2] + vb[j][3] * vb[j][3]); }
#pragma unroll
        for (int o = 1; o < 64; o <<= 1) { sa += __shfl_xor(sa, o); sb += __shfl_xor(sb, o); }
        norm_row16_finish(m, va, sa, gain, mod, shofs, scofs, XN, lane);
        if (two) norm_row16_finish(m2, vb, sb, gain, mod, shofs, scofs, XN, lane);
    }
}

DI void norm_phase_f32w(const float* srcP, const float* srcS, const float* gain, const float* mod, int shofs, int scofs, bf16_t* XN, int wave, int lane) {
    const int gw = blockIdx.x * 8 + wave, NGW = gridDim.x * 8;
    for (int m = gw; m < M; m += 2 * NGW) {
        const int m2 = m + NGW; const bool two = m2 < M; const int mb2 = two ? m2 : m;
        const float* xa = m < MP ? srcP + (size_t)m * D : srcS + (size_t)(m - MP) * D;
        const float* xb = mb2 < MP ? srcP + (size_t)mb2 * D : srcS + (size_t)(mb2 - MP) * D;
        f32x4 va[4], vb[4]; float sa = 0.f, sb = 0.f;
#pragma unroll
        for (int j = 0; j < 2; ++j) { const int c = 8 * (64 * j + lane);
            va[2 * j] = *(const f32x4*)(xa + c); va[2 * j + 1] = *(const f32x4*)(xa + c + 4); vb[2 * j] = *(const f32x4*)(xb + c); vb[2 * j + 1] = *(const f32x4*)(xb + c + 4); }
#pragma unroll
        for (int j = 0; j < 4; ++j) { sa += (va[j][0] * va[j][0] + va[j][1] * va[j][1]) + (va[j][2] * va[j][2] + va[j][3] * va[j][3]); sb += (vb[j][0] * vb[j][0] + vb[j][1] * vb[j][1]) + (vb[j][2] * vb[j][2] + vb[j][3] * vb[j][3]); }
#pragma unroll
        for (int o = 1; o < 64; o <<= 1) { sa += __shfl_xor(sa, o); sb += __shfl_xor(sb, o); }
        norm_row16_finish(m, va, sa, gain, mod, shofs, scofs, XN, lane);
        if (two) norm_row16_finish(m2, vb, sb, gain, mod, shofs, scofs, XN, lane);
    }
}

DI void sb_tile(f32x16& O0, f32x16& O1, float& carry, const bf16x8 (&qf)[4], const bf16x8 (&kf)[4], const bf16x8 (&vf)[2][2], bool diag, int lane) {
    f32x16 S;
#pragma unroll
    for (int i = 0; i < 16; ++i) S[i] = 0.f;
#pragma unroll
    for (int ks = 0; ks < 4; ++ks) S = MFMA32(kf[ks], qf[ks], S);
    const int h = lane >> 5, qn = lane & 31;
    float beta[16], ein[16], G[4];
#pragma unroll
    for (int g = 0; g < 4; ++g) {
        float av[4];
#pragma unroll
        for (int r = 0; r < 4; ++r) {
            const int i = 4 * g + r;
            const float z = __builtin_fmaxf(S[i], -100.f);
            const float t = ex2(-z);
            float b = __builtin_amdgcn_rcpf(1.f + t), a = t * b;
            if (diag) { const bool ok = (8 * g + 4 * h + r) < qn; b = ok ? b : 0.f; a = ok ? a : 1.f; }
            beta[i] = b; av[r] = a;
        }
        ein[4 * g + 3] = 1.f; ein[4 * g + 2] = av[3]; ein[4 * g + 1] = av[3] * av[2]; ein[4 * g] = ein[4 * g + 1] * av[1]; G[g] = ein[4 * g] * av[0];
    }
    float Go[4], PP[4], later[4];
#pragma unroll
    for (int g = 0; g < 4; ++g) { Go[g] = __shfl_xor(G[g], 32); PP[g] = G[g] * Go[g]; }
    later[3] = carry; later[2] = later[3] * PP[3]; later[1] = later[2] * PP[2]; later[0] = later[1] * PP[1];
    carry = later[0] * PP[0];
    f32x16 W;
#pragma unroll
    for (int g = 0; g < 4; ++g) {
        const float lt = later[g] * (h == 0 ? Go[g] : 1.f);
#pragma unroll
        for (int r = 0; r < 4; ++r) W[4 * g + r] = beta[4 * g + r] * ein[4 * g + r] * lt;
    }
#pragma unroll
    for (int s = 0; s < 2; ++s) { const bf16x8 wb = pack8(W, s); O0 = MFMA32(vf[0][s], wb, O0); O1 = MFMA32(vf[1][s], wb, O1); }
}
DI void sb_item(int item, const Args& a, int lane) {
    unsigned char* ws = a.ws;
    const bf16_t* SBQ = (const bf16_t*)(ws + WS_SBQ); const bf16_t* SBK = (const bf16_t*)(ws + WS_SBK); const bf16_t* SBVT = (const bf16_t*)(ws + WS_SBVT);
    bf16_t* MIX = (bf16_t*)(ws + WS_MIX);
    const int head = item & 7, gt = item >> 3, row0 = gt * 32, h = lane >> 5, ln = lane & 31;
    bf16x8 qf[4];
#pragma unroll
    for (int ks = 0; ks < 4; ++ks) qf[ks] = ld8(SBQ + (size_t)(row0 + ln) * 512 + head * 64 + 16 * ks + 8 * h);
    f32x16 O0, O1;
#pragma unroll
    for (int i = 0; i < 16; ++i) { O0[i] = 0.f; O1[i] = 0.f; }
    float carry = 1.f;
    const bool prompt = row0 < MP;
    const int gt_last = prompt ? (gt & ~255) : (gt & ~1);
    bool done = false;
    {
        bf16x8 kf[4], vf[2][2];
#pragma unroll
        for (int ks = 0; ks < 4; ++ks) kf[ks] = ld8(SBK + (size_t)(gt * 32 + ln) * 512 + head * 64 + 16 * ks + 8 * h);
#pragma unroll
        for (int ds = 0; ds < 2; ++ds)
#pragma unroll
            for (int s = 0; s < 2; ++s) vf[ds][s] = ld44(SBVT + (((size_t)(gt * 8 + head) * 4 + 2 * s) * 64 + 32 * ds + ln) * 8 + 4 * h, 512);
        for (int kt = gt;; --kt) {
            const bool more = kt > gt_last;
            bf16x8 kn[4], vn[2][2];
            const int kp = more ? kt - 1 : kt;
#pragma unroll
            for (int ks = 0; ks < 4; ++ks) kn[ks] = ld8(SBK + (size_t)(kp * 32 + ln) * 512 + head * 64 + 16 * ks + 8 * h);
#pragma unroll
            for (int ds = 0; ds < 2; ++ds)
#pragma unroll
                for (int s = 0; s < 2; ++s) vn[ds][s] = ld44(SBVT + (((size_t)(kp * 8 + head) * 4 + 2 * s) * 64 + 32 * ds + ln) * 8 + 4 * h, 512);
            __builtin_amdgcn_sched_barrier(0);
            sb_tile(O0, O1, carry, qf, kf, vf, kt == gt, lane);
            asm volatile("" :: "v"(kn[0]), "v"(kn[1]), "v"(kn[2]), "v"(kn[3]), "v"(vn[0][0]), "v"(vn[0][1]), "v"(vn[1][0]), "v"(vn[1][1]));
            if (__all(carry < SB_EXIT)) { done = true; break; }
            if (!more) break;
#pragma unroll
            for (int ks = 0; ks < 4; ++ks) kf[ks] = kn[ks];
#pragma unroll
            for (int ds = 0; ds < 2; ++ds)
#pragma unroll
                for (int s = 0; s < 2; ++s) vf[ds][s] = vn[ds][s];
        }
    }
    if (!prompt && !done) {
        const int bs = (row0 - MP) >> 6;
        const float* ck = a.in[2] + (size_t)bs * 2048 * 512 + head * 64;
        const float* cv = a.in[3] + (size_t)bs * 2048 * 512 + head * 64;
        for (int t0 = 2048 - 32; t0 >= 0; t0 -= 32) {
            bf16x8 kf[4], vf[2][2];
#pragma unroll
            for (int ks = 0; ks < 4; ++ks) {
                const f32x4* p = (const f32x4*)(ck + (size_t)(t0 + ln) * 512 + 16 * ks + 8 * h);
                const f32x4 x0 = p[0], x1 = p[1];
                u32x4 w; w.x = pk2(x0[0], x0[1]); w.y = pk2(x0[2], x0[3]); w.z = pk2(x1[0], x1[1]); w.w = pk2(x1[2], x1[3]);
                kf[ks] = __builtin_bit_cast(bf16x8, w);
            }
#pragma unroll
            for (int ds = 0; ds < 2; ++ds)
#pragma unroll
                for (int s = 0; s < 2; ++s) {
                    float x[8];
#pragma unroll
                    for (int j = 0; j < 8; ++j) x[j] = cv[(size_t)(t0 + 16 * s + 8 * (j >> 2) + 4 * h + (j & 3)) * 512 + 32 * ds + ln];
                    u32x4 w; w.x = pk2(x[0], x[1]); w.y = pk2(x[2], x[3]); w.z = pk2(x[4], x[5]); w.w = pk2(x[6], x[7]);
                    vf[ds][s] = __builtin_bit_cast(bf16x8, w);
                }
            sb_tile(O0, O1, carry, qf, kf, vf, false, lane);
            if (__all(carry < SB_EXIT)) break;
        }
    }
    bf16_t* op = MIX + (size_t)(row0 + ln) * D + head * 64 + 4 * h;
#pragma unroll
    for (int g = 0; g < 4; ++g) {
        u32x2 w0, w1; w0.x = pk2(O0[4 * g], O0[4 * g + 1]); w0.y = pk2(O0[4 * g + 2], O0[4 * g + 3]); w1.x = pk2(O1[4 * g], O1[4 * g + 1]); w1.y = pk2(O1[4 * g + 2], O1[4 * g + 3]);
        *(u32x2*)(op + 8 * g) = w0; *(u32x2*)(op + 32 + 8 * g) = w1;
    }
}

DI void ret_update(f32x16 (&T)[4], const bf16_t* kt, const bf16_t* vt, float c, int slice, int lane) {
    const int h = lane >> 5, ln = lane & 31;
    bf16x8 vfr[4];
#pragma unroll
    for (int ks = 0; ks < 4; ++ks) vfr[ks] = ld8(vt + ((size_t)(2 * ks + h) * 128 + 32 * slice + ln) * 8);
#pragma unroll
    for (int ms = 0; ms < 4; ++ms) {
        T[ms] = T[ms] * c;
#pragma unroll
        for (int ks = 0; ks < 4; ++ks) T[ms] = MFMA32(ld8(kt + ((size_t)(2 * ks + h) * 128 + 32 * ms + ln) * 8), vfr[ks], T[ms]);
    }
}
DI void ret_loadA(bf16x8 (&kfr)[4][4], bf16x8 (&vfr)[4], const bf16_t* kt, const bf16_t* vt, int slice, int lane) {
    const int h = lane >> 5, ln = lane & 31;
#pragma unroll
    for (int ks = 0; ks < 4; ++ks) vfr[ks] = ld8(vt + ((size_t)(2 * ks + h) * 128 + 32 * slice + ln) * 8);
#pragma unroll
    for (int ms = 0; ms < 4; ++ms)
#pragma unroll
        for (int ks = 0; ks < 4; ++ks) kfr[ms][ks] = ld8(kt + ((size_t)(2 * ks + h) * 128 + 32 * ms + ln) * 8);
}
DI void ret_passA(int item, unsigned char* ws, int lane) {
    const int slice = item & 3, g = (item >> 2) % (NG - 1), bh = item / (4 * (NG - 1)), b = bh >> 2, head = bh & 3;
    const float c = ex2(64.f * lg_gamma(head));
    f32x16 T[4];
#pragma unroll
    for (int ms = 0; ms < 4; ++ms)
#pragma unroll
        for (int i = 0; i < 16; ++i) T[ms][i] = 0.f;
    const size_t cg0 = (size_t)(b * 128 + g * CG);
    const bf16_t* KT = (const bf16_t*)(ws + WS_RKT); const bf16_t* VT = (const bf16_t*)(ws + WS_RVT);
    bf16x8 kfr[4][4], vfr[4];
    ret_loadA(kfr, vfr, KT + (cg0 * 4 + head) * 8192, VT + (cg0 * 4 + head) * 8192, slice, lane);
    for (int step = 0; step < CG; ++step) {
        bf16x8 kn[4][4], vn[4];
        const size_t cgn = cg0 + (step < CG - 1 ? step + 1 : step);
        ret_loadA(kn, vn, KT + (cgn * 4 + head) * 8192, VT + (cgn * 4 + head) * 8192, slice, lane);
#pragma unroll
        for (int ms = 0; ms < 4; ++ms) {
            T[ms] = T[ms] * c;
#pragma unroll
            for (int ks = 0; ks < 4; ++ks) T[ms] = MFMA32(kfr[ms][ks], vfr[ks], T[ms]);
        }
#pragma unroll
        for (int ks = 0; ks < 4; ++ks) { vfr[ks] = vn[ks];
#pragma unroll
            for (int ms = 0; ms < 4; ++ms) kfr[ms][ks] = kn[ms][ks]; }
    }
    float* o = (float*)(ws + WS_LT) + (size_t)item * 4096;
#pragma unroll
    for (int ms = 0; ms < 4; ++ms)
#pragma unroll
        for (int i = 0; i < 16; ++i) o[(ms * 16 + i) * 64 + lane] = T[ms][i];
}
constexpr int RB_Q = 0, RB_K = 17408, RB_KT = 34816, RB_VT = 51200, RB_BYTES = 67584, RB_ROW = 272, RB_STATS = 2 * RB_BYTES;
DI bf16x8 lds8(const LAS unsigned char* p) { return *(const LAS bf16x8*)p; }
DI bf16x8 lds44(const LAS unsigned char* p, int stride_bytes) {
    const s16x4 lo = *(const LAS s16x4*)p, hi = *(const LAS s16x4*)(p + stride_bytes);
    return __builtin_shufflevector(lo, hi, 0, 1, 2, 3, 4, 5, 6, 7);
}
DI void ret_stage_load(u32x4 (&r)[16], const bf16_t* RQ, const bf16_t* RK, const bf16_t* kt, const bf16_t* vt, int rc, int head, int t) {
#pragma unroll
    for (int i = 0; i < 4; ++i) { const int q = t + 256 * i; r[i] = *(const u32x4*)(RQ + (size_t)(rc + (q >> 4)) * 512 + head * 128 + (q & 15) * 8); }
#pragma unroll
    for (int i = 0; i < 4; ++i) { const int q = t + 256 * i; r[4 + i] = *(const u32x4*)(RK + (size_t)(rc + (q >> 4)) * 512 + head * 128 + (q & 15) * 8); }
#pragma unroll
    for (int i = 0; i < 4; ++i) { const int q = t + 256 * i; r[8 + i] = *(const u32x4*)(kt + (size_t)q * 8); }
#pragma unroll
    for (int i = 0; i < 4; ++i) { const int q = t + 256 * i; r[12 + i] = *(const u32x4*)(vt + (size_t)q * 8); }
}
DI void ret_stage_store(const u32x4 (&r)[16], LAS unsigned char* buf, int t) {
#pragma unroll
    for (int i = 0; i < 4; ++i) { const int q = t + 256 * i; *(LAS u32x4*)(buf + RB_Q + (q >> 4) * RB_ROW + (q & 15) * 16) = r[i]; }
#pragma unroll
    for (int i = 0; i < 4; ++i) { const int q = t + 256 * i; *(LAS u32x4*)(buf + RB_K + (q >> 4) * RB_ROW + (q & 15) * 16) = r[4 + i]; }
#pragma unroll
    for (int i = 0; i < 4; ++i) { const int q = t + 256 * i; *(LAS u32x4*)(buf + RB_KT + q * 16) = r[8 + i]; }
#pragma unroll
    for (int i = 0; i < 4; ++i) { const int q = t + 256 * i; *(LAS u32x4*)(buf + RB_VT + q * 16) = r[12 + i]; }
}
DI void ret_block(int mode, int ci, const Args& a, LAS unsigned char* lds, int tid, int wave, int lane) {
    unsigned char* ws = a.ws;
    const bf16_t* RQ = (const bf16_t*)(ws + WS_RQ); const bf16_t* RK = (const bf16_t*)(ws + WS_RK);
    int head, row0, nsteps;
    if (mode == 0) { const int bh = ci / NG, g = ci % NG, b = bh >> 2; head = bh & 3; row0 = b * 8192 + g * (64 * CG); nsteps = CG; }
    else { const int bs = ci >> 2; head = ci & 3; row0 = MP + 64 * bs; nsteps = 1; }
    if (wave >= 4) {
        const int lt_ = tid - 256;
        {
            u32x4 r[16]; const size_t cgk = (size_t)(row0 >> 6);
            ret_stage_load(r, RQ, RK, (const bf16_t*)(ws + WS_RKT) + (cgk * 4 + head) * 8192, (const bf16_t*)(ws + WS_RVT) + (cgk * 4 + head) * 8192, row0, head, lt_);
            ret_stage_store(r, lds, lt_);
        }
        __syncthreads();
        for (int step = 0; step < nsteps; ++step) {
            const int rc = row0 + 64 * step;
            LAS unsigned char* nxt = lds + ((step + 1) & 1) * RB_BYTES;
            u32x4 r[16];
            const bool more = step + 1 < nsteps;
            if (more) {
                const size_t cgk = (size_t)((rc + 64) >> 6);
                ret_stage_load(r, RQ, RK, (const bf16_t*)(ws + WS_RKT) + (cgk * 4 + head) * 8192, (const bf16_t*)(ws + WS_RVT) + (cgk * 4 + head) * 8192, rc + 64, head, lt_);
            }
            __syncthreads();
            if (more) ret_stage_store(r, nxt, lt_);
            __syncthreads();
        }
        return;
    }
    const int slice = wave & 3, h = lane >> 5, ln = lane & 31;
    const bf16_t* RG = (const bf16_t*)(ws + WS_RG);
    bf16_t* MIX = (bf16_t*)(ws + WS_MIX);
    LAS float* stats = (LAS float*)(lds + RB_STATS);
    float* sout;
    f32x16 T[4];
    if (mode == 0) {
        const int bh = ci / NG, g = ci % NG;
        sout = (g == NG - 1) ? a.out + O_SP + (size_t)bh * 16384 : nullptr;
        const float c16 = ex2((float)(64 * CG) * lg_gamma(head));
#pragma unroll
        for (int ms = 0; ms < 4; ++ms)
#pragma unroll
            for (int i = 0; i < 16; ++i) T[ms][i] = 0.f;
        if (g > 0) {
            const float* lt0 = (const float*)(ws + WS_LT) + (size_t)((bh * (NG - 1)) * 4 + slice) * 4096 + lane;
            f32x16 L[4];
#pragma unroll
            for (int ms = 0; ms < 4; ++ms)
#pragma unroll
                for (int i = 0; i < 16; ++i) L[ms][i] = lt0[(ms * 16 + i) * 64];
            for (int gp = 0; gp < g; ++gp) {
                f32x16 N[4];
                const float* ltn = lt0 + (size_t)((gp + 1 < g ? gp + 1 : gp) * 4) * 4096;
#pragma unroll
                for (int ms = 0; ms < 4; ++ms)
#pragma unroll
                    for (int i = 0; i < 16; ++i) N[ms][i] = ltn[(ms * 16 + i) * 64];
#pragma unroll
                for (int ms = 0; ms < 4; ++ms) { T[ms] = T[ms] * c16 + L[ms]; L[ms] = N[ms]; }
            }
        }
    } else {
        sout = a.out + O_SS + (size_t)ci * 16384;
        const float* s0 = a.in[4] + (size_t)ci * 16384;
        const float ig = ex2(-63.f * lg_gamma(head));
#pragma unroll
        for (int ms = 0; ms < 4; ++ms)
#pragma unroll
            for (int i = 0; i < 16; ++i) T[ms][i] = s0[(32 * ms + 8 * (i >> 2) + 4 * h + (i & 3)) * 128 + 32 * slice + ln] * ig;
    }
    const float c = ex2(64.f * lg_gamma(head));
    __syncthreads();
    for (int step = 0; step < nsteps; ++step) {
        const int rc = row0 + 64 * step;
        const LAS unsigned char* cur = lds + (step & 1) * RB_BYTES;
        LAS float* st = stats + (step & 1) * 512;
        f32x16 out[2]; u32x2 gt[2][4];
#pragma unroll
        for (int is = 0; is < 2; ++is)
#pragma unroll
            for (int g4 = 0; g4 < 4; ++g4) gt[is][g4] = *(const u32x2*)(RG + (size_t)(rc + 32 * is + ln) * 512 + head * 128 + 32 * slice + 8 * g4 + 4 * h);
#pragma unroll
        for (int is = 0; is < 2; ++is)
#pragma unroll
            for (int i = 0; i < 16; ++i) out[is][i] = 0.f;
        const LAS unsigned char* qrow = cur + RB_Q + ln * RB_ROW; const LAS unsigned char* krow = cur + RB_K + ln * RB_ROW;
#pragma unroll
        for (int ms = 0; ms < 4; ++ms)
#pragma unroll
            for (int s = 0; s < 2; ++s) {
                const bf16x8 tb = pack8(T[ms], s);
#pragma unroll
                for (int is = 0; is < 2; ++is) out[is] = MFMA32(tb, lds44(qrow + is * 32 * RB_ROW + (32 * ms + 16 * s + 4 * h) * 2, 16), out[is]);
            }
#pragma unroll
        for (int is = 0; is < 2; ++is) out[is] = out[is] * c;
#pragma unroll
        for (int blk = 0; blk < 3; ++blk) {
            const int js = blk == 2 ? 1 : 0, is = blk == 0 ? 0 : 1;
            f32x16 P;
#pragma unroll
            for (int i = 0; i < 16; ++i) P[i] = 0.f;
#pragma unroll
            for (int ks = 0; ks < 8; ++ks) P = MFMA32(lds8(krow + js * 32 * RB_ROW + (16 * ks + 8 * h) * 2), lds8(qrow + is * 32 * RB_ROW + (16 * ks + 8 * h) * 2), P);
            if (js == is) {
#pragma unroll
                for (int i = 0; i < 16; ++i) P[i] = (8 * (i >> 2) + 4 * h + (i & 3)) <= ln ? P[i] : 0.f;
            }
#pragma unroll
            for (int s = 0; s < 2; ++s) out[is] = MFMA32(lds44(cur + RB_VT + ((4 * js + 2 * s) * 128 + 32 * slice + ln) * 16 + 8 * h, 2048), pack8(P, s), out[is]);
        }
        {
            bf16x8 vfr[4];
#pragma unroll
            for (int ks = 0; ks < 4; ++ks) vfr[ks] = lds8(cur + RB_VT + ((2 * ks + h) * 128 + 32 * slice + ln) * 16);
#pragma unroll
            for (int ms = 0; ms < 4; ++ms) {
                T[ms] = T[ms] * c;
#pragma unroll
                for (int ks = 0; ks < 4; ++ks) T[ms] = MFMA32(lds8(cur + RB_KT + ((2 * ks + h) * 128 + 32 * ms + ln) * 16), vfr[ks], T[ms]);
            }
        }
#pragma unroll
        for (int is = 0; is < 2; ++is) {
            float s1 = 0.f, s2 = 0.f;
#pragma unroll
            for (int i = 0; i < 16; ++i) { s1 += out[is][i]; s2 += out[is][i] * out[is][i]; }
            s1 += __shfl_xor(s1, 32); s2 += __shfl_xor(s2, 32);
            if (h == 0) { st[slice * 128 + 2 * (32 * is + ln)] = s1; st[slice * 128 + 2 * (32 * is + ln) + 1] = s2; }
        }
        __syncthreads();
#pragma unroll
        for (int is = 0; is < 2; ++is) {
            float t1 = 0.f, t2 = 0.f;
#pragma unroll
            for (int sl = 0; sl < 4; ++sl) { t1 += st[sl * 128 + 2 * (32 * is + ln)]; t2 += st[sl * 128 + 2 * (32 * is + ln) + 1]; }
            const float mean = t1 * (1.f / 128.f), var = __builtin_fmaxf(t2 * (1.f / 128.f) - mean * mean, 0.f), rstd = __builtin_amdgcn_rsqf(var + EPS);
            const size_t row = (size_t)(rc + 32 * is + ln);
#pragma unroll
            for (int g4 = 0; g4 < 4; ++g4) {
                const int d0 = 32 * slice + 8 * g4 + 4 * h;
                const u32x2 gg = gt[is][g4];
                const float g0 = __builtin_bit_cast(float, gg.x << 16), g1 = __builtin_bit_cast(float, gg.x & 0xffff0000u), g2 = __builtin_bit_cast(float, gg.y << 16), g3 = __builtin_bit_cast(float, gg.y & 0xffff0000u);
                u32x2 w; w.x = pk2((out[is][4 * g4] - mean) * rstd * g0, (out[is][4 * g4 + 1] - mean) * rstd * g1);
                w.y = pk2((out[is][4 * g4 + 2] - mean) * rstd * g2, (out[is][4 * g4 + 3] - mean) * rstd * g3);
                *(u32x2*)(MIX + row * D + 512 + head * 128 + d0) = w;
            }
        }
        __syncthreads();
    }
    if (sout) {
        const float gsc = ex2(63.f * lg_gamma(head));
#pragma unroll
        for (int ms = 0; ms < 4; ++ms)
#pragma unroll
            for (int i = 0; i < 16; ++i) sout[(32 * ms + 8 * (i >> 2) + 4 * h + (i & 3)) * 128 + 32 * slice + ln] = T[ms][i] * gsc;
    }
}

#define RLX_AGENT __ATOMIC_RELAXED, __HIP_MEMORY_SCOPE_AGENT
#define XB_TMO      128
#define XB_XCNT(j)  (256  + 64 * (j))
#define XB_XSUB(j)  (1280 + 64 * (j))
#define XB_XGEN(j)  (2304 + 64 * (j))
#define XB_TOP      3328
#define XB_TOPGEN   3392
#define XCD_BAR_WORDS 3456
#define XB_SPIN_CAP (1u << 18)

__device__ __forceinline__ unsigned xb_ld(unsigned* p)              { return __hip_atomic_load(p, __ATOMIC_RELAXED, __HIP_MEMORY_SCOPE_AGENT); }
__device__ __forceinline__ unsigned xb_add(unsigned* p, unsigned v) { return __hip_atomic_fetch_add(p, v, __ATOMIC_RELAXED, __HIP_MEMORY_SCOPE_AGENT); }
__device__ __forceinline__ unsigned xb_xcc_id() { return (unsigned)__builtin_amdgcn_s_getreg((3 << 11) | 20) & 0xFu; }
#define XB_SPIN(cond, bar) do { unsigned _sp = 0; while (cond) { __builtin_amdgcn_s_sleep(1); \
    if ((++_sp & 255u) == 0u) { if (xb_ld(&(bar)[XB_TMO])) break; if (_sp > XB_SPIN_CAP) { atomicAdd(&(bar)[XB_TMO], 1u); break; } } } } while (0)

struct XcdBarrier {
    unsigned* bar; unsigned x;
    volatile LAS unsigned* st;
};

__device__ __forceinline__ XcdBarrier xcd_barrier_post(unsigned* bar, volatile LAS unsigned* st) {
    XcdBarrier b; b.bar = bar; b.x = xb_xcc_id(); b.st = st;
    if (threadIdx.x == 0) (void)xb_add(&bar[XB_XCNT(b.x)], 1u);
    return b;
}
__device__ __forceinline__ void xcd_barrier_complete(unsigned* bar, unsigned x, unsigned& nloc, unsigned& nx) {
    const unsigned G = gridDim.x * gridDim.y * gridDim.z;
    unsigned sum, cnt, mine, sp = 0u;
    for (;;) {
        sum = 0u; cnt = 0u; mine = 0u;
#pragma unroll
        for (unsigned j = 0; j < 16; ++j) { const unsigned c = xb_ld(&bar[XB_XCNT(j)]); sum += c; cnt += (c > 0u) ? 1u : 0u; mine = (j == x) ? c : mine; }
        if (sum == G) break;
        __builtin_amdgcn_s_sleep(1);
        if ((++sp & 255u) == 0u) { if (xb_ld(&bar[XB_TMO])) break; if (sp > XB_SPIN_CAP) { atomicAdd(&bar[XB_TMO], 1u); break; } }
    }
    nloc = mine > 0u ? mine : 1u; nx = cnt > 0u ? cnt : 1u;
}

__device__ __forceinline__ void xcd_barrier(const XcdBarrier& b) {
    asm volatile("s_waitcnt vmcnt(0)" ::: "memory");
    __syncthreads();
    if (threadIdx.x == 0) {
        unsigned* bar = b.bar;
        __builtin_amdgcn_s_waitcnt(0);
        unsigned nloc = b.st[0], nx = b.st[1];
        if (nloc == 0u) { xcd_barrier_complete(bar, b.x, nloc, nx); b.st[0] = nloc; b.st[1] = nx; }
        const unsigned old = xb_add(&bar[XB_XSUB(b.x)], 1u);
        const unsigned gen = old / nloc;
        if (old + 1u == (gen + 1u) * nloc) {
            __builtin_amdgcn_fence(__ATOMIC_RELEASE, "agent");
            asm volatile("s_waitcnt vmcnt(0)" ::: "memory");
            const unsigned og = xb_add(&bar[XB_TOP], 1u);
            const unsigned tg = og / nx;
            if (og + 1u == (tg + 1u) * nx) xb_add(&bar[XB_TOPGEN], 1u);
            else XB_SPIN(xb_ld(&bar[XB_TOPGEN]) == tg, bar);
            __builtin_amdgcn_fence(__ATOMIC_ACQUIRE, "agent");
            xb_add(&bar[XB_XGEN(b.x)], 1u);
            asm volatile("s_waitcnt vmcnt(0)" ::: "memory");
        } else {
            XB_SPIN(xb_ld(&bar[XB_XGEN(b.x)]) == gen, bar);
            __builtin_amdgcn_fence(__ATOMIC_ACQUIRE, "agent");
            asm volatile("s_waitcnt vmcnt(0)" ::: "memory");
        }
    }
    __syncthreads();
}

__global__ void __launch_bounds__(512, 2) fwd(Args a) {
    extern __shared__ __attribute__((aligned(16))) unsigned char lds_raw[];
    LAS unsigned char* lds = (LAS unsigned char*)lds_raw;
    cg::grid_group grid = cg::this_grid();
    const int tid0 = threadIdx.x;
    unsigned char* ws = a.ws;
    volatile LAS unsigned* bst = (volatile LAS unsigned*)(lds + LDS_BYTES - 64);
    if (tid0 < 2) bst[tid0] = 0u;
    __syncthreads();
    XcdBarrier bar; bar.bar = (unsigned*)(ws + WS_BAR); bar.x = 0; bar.st = bst;
    float* mod = (float*)(ws + WS_MOD);
    bf16_t* XN = (bf16_t*)(ws + WS_XN);
    constexpr int NPI = 12 + (PH_DUP >= 0 ? 1 : 0);
    for (int pi = 0; pi < NPI; ++pi) {
        const int ph = (PH_DUP >= 0 && pi > PH_DUP) ? pi - 1 : pi;
        int tid = tid0; asm volatile("" : "+v"(tid));
        const int lane = tid & 63, wave = __builtin_amdgcn_readfirstlane(tid >> 6);
        if (ph == 0 && PHON(0)) {
            p0_prologue(a, lds, tid, wave, lane, pi == 0);
        } else if ((ph == 1 || ph == 4 || ph == 9) && PHON(1)) {
            const float* sP = ph == 1 ? a.in[0] : a.out; const float* sS = ph == 1 ? a.in[1] : a.out + (size_t)MP * D;
            const float* gain = ph == 1 ? a.in[9] : ph == 4 ? a.in[10] : a.in[11];
            const int k = ph == 1 ? 0 : ph == 4 ? 3 : 6;
            if (ph == 1) norm_phase_f32w(sP, sS, gain, mod, k * D, (k + 1) * D, XN, wave, lane);
            else norm_phase_b16((const bf16_t*)(ws + WS_XB), gain, mod, k * D, (k + 1) * D, XN, wave, lane);
        } else if ((ph == 2 || ph == 10) && PHON(2)) {
            pg8::Gemm g{XN, (const bf16_t*)(ws + (ph == 2 ? WS_WUP1 : WS_WUP2)), M, NUP, D, 0}; pg8::StaticOrder S; S.init(M, NUP, D, (int)gridDim.x, (int)blockIdx.x);
            EpiSwiGLU E{(bf16_t*)(ws + WS_ACT)};
            pg8::gemm_phase<EpiSwiGLU, pg8::StaticOrder, true, true>(lds, g, S, E);
        } else if ((ph == 3 || ph == 8 || ph == 11) && PHON(3)) {
            const bf16_t* A = (const bf16_t*)(ws + (ph == 8 ? WS_MIX : WS_ACT));
            const bf16_t* W = (const bf16_t*)(ws + (ph == 3 ? WS_WDN1 : ph == 8 ? WS_WOUT : WS_WDN2));
            pg8::Gemm g{A, W, M, D, ph == 8 ? D : FF, ph == 8 ? 0 : 1}; pg8::StaticOrder S; S.init(M, D, ph == 8 ? D : FF, (int)gridDim.x, (int)blockIdx.x);
            EpiResid E{a.in[0], a.in[1], a.out, mod, (ph == 3 ? 2 : ph == 8 ? 5 : 8) * D, ph == 8 ? 1.f : 0.5f, ph == 3 ? 0 : ph == 8 ? 1 : 2};
            pg8::gemm_phase<EpiResid, pg8::StaticOrder, true, true>(lds, g, S, E);
        } else if (ph == 5 && PHON(5)) {
            pg8::Gemm g{XN, (const bf16_t*)(ws + WS_WIN), M, NIN, D, 0}; pg8::StaticOrder S; S.init(M, NIN, D, (int)gridDim.x, (int)blockIdx.x);
            EpiIn E{a.in[15], a.in[16], (const f32x2*)(ws + WS_ROPE), a.out, ws};
            pg8::gemm_phase<EpiIn, pg8::StaticOrder, true, true>(lds, g, S, E);
        } else if (ph == 6 && PHON(6)) {
            unsigned* q = (unsigned*)(ws + WS_CTL) + 64 + 512 * (pi & 1);
            const int x0 = (int)(xb_xcc_id() & 7u);
            constexpr int QS = 64, QA = (16 * (NG - 1) * 4) / 8, QP = (MP / 32) * 8 / 8, QN = QS + QA + QP;
            for (int dx = 0; dx < 8; ++dx) {
                const int x = (x0 + dx) & 7;
                for (;;) {
                    unsigned k = 0;
                    if (lane == 0) k = __hip_atomic_fetch_add(q + 64 * x, 1u, __ATOMIC_RELAXED, __HIP_MEMORY_SCOPE_AGENT);
                    k = (unsigned)__builtin_amdgcn_readfirstlane((int)k);
                    if (k >= (unsigned)QN) break;
                    if (k >= (unsigned)QS && k < (unsigned)(QS + QA)) ret_passA(x * QA + (int)k - QS, ws, lane);
                    else sb_item(k < (unsigned)QS ? (MP / 32) * 8 + x * QS + (int)k : x * QP + (int)k - (QS + QA), a, lane);
                }
            }
        } else if (ph == 7 && PHON(7)) {
            const int G = (int)gridDim.x, nit = 16 * NG + 128;
            for (int k = 0;; ++k) {
                int bi;
                if (G == 16 * NG) { const int g = (int)blockIdx.x % NG; if (k == 0) bi = (int)blockIdx.x; else if (k == 1 && g < NG / 2) bi = 16 * NG + ((int)blockIdx.x / NG) * (NG / 2) + g; else break; }
                else { bi = (int)blockIdx.x + k * G; if (bi >= nit) break; }
                ret_block(bi >= 16 * NG, bi >= 16 * NG ? bi - 16 * NG : bi, a, lds, tid, wave, lane);
            }
        }
        if (pi == 0) { grid.sync(); bar = xcd_barrier_post((unsigned*)(ws + WS_BAR), bst); }
        else if (pi < NPI - 1) xcd_barrier(bar);
        if (PHREP(12)) xcd_barrier(bar);
    }
}
}

extern "C" void kernel_launch(void* const* d_in, const int* in_sizes, int n_in, void* d_out, int out_size, void* d_ws, size_t ws_size, hipStream_t stream) {
    static int grid = 0;
    if (grid == 0) {
        if (n_in != 20 || ws_size < mk::WS_END) { fprintf(stderr, "kernel_launch: unexpected inputs (n_in %d, ws %zu)\n", n_in, ws_size); grid = -1; return; }
        int dev = 0, cus = 0, per_cu = 0;
        hipGetDevice(&dev);
        hipDeviceGetAttribute(&cus, hipDeviceAttributeMultiprocessorCount, dev);
        hipFuncSetAttribute((const void*)mk::fwd, hipFuncAttributeMaxDynamicSharedMemorySize, mk::LDS_BYTES);
        hipOccupancyMaxActiveBlocksPerMultiprocessor(&per_cu, (const void*)mk::fwd, 512, mk::LDS_BYTES);
        if (per_cu < 1) per_cu = 1;
        grid = cus * per_cu;
        (void)hipGetLastError();
    }
    if (grid < 0) return;
    mk::Args a{};
    for (int i = 0; i < 20; ++i) a.in[i] = (const float*)d_in[i];
    a.out = (float*)d_out; a.ws = (unsigned char*)d_ws;
    void* args[] = {&a};
    hipError_t e = hipLaunchCooperativeKernel((const void*)mk::fwd, dim3(grid), dim3(512), args, mk::LDS_BYTES, stream);
    if (e != hipSuccess) fprintf(stderr, "cooperative launch failed: %s (grid %d)\n", hipGetErrorString(e), grid);
}
```
